# Optimizing an MI355X kernel written in HIP

```python
import jax, jax.numpy as jnp
from jax import lax
import numpy as np

D_MODEL = 2048
BATCH = 4
SEQ = 2048
DEPTH = 4

A_WIDTH = D_MODEL // 2
A_GROUPS = 8
A_GROUP_DIM = A_WIDTH // A_GROUPS
CHUNK = 128
B_HEAD_DIM = 64
B_Q_HEADS = (D_MODEL // 2) // B_HEAD_DIM
B_KV_HEADS = 2
B_WIDTH = B_Q_HEADS * B_HEAD_DIM
B_KV_WIDTH = B_KV_HEADS * B_HEAD_DIM
WINDOW = 128
ROT_DIM = B_HEAD_DIM // 4
ROPE_THETA = 500000.0
C_WIDTH = D_MODEL // 2
C_HEADS = 8
C_HEAD_DIM = C_WIDTH // C_HEADS
CONV_WIDTH = 4
LRU_C = 8.0
D_WIDTH = D_MODEL // 2
POOL_WINDOWS = (2, 4, 8, 16)
D_GROUPS = len(POOL_WINDOWS)
D_GROUP_DIM = D_WIDTH // D_GROUPS

EVEN_SIZES = (A_WIDTH, A_WIDTH, A_WIDTH, B_WIDTH, B_KV_WIDTH, B_KV_WIDTH, B_WIDTH)
ODD_SIZES = (C_WIDTH, C_WIDTH, D_WIDTH, D_WIDTH)
EVEN_IN = sum(EVEN_SIZES)
ODD_IN = sum(ODD_SIZES)
EVEN_MIX = A_WIDTH + B_WIDTH
ODD_MIX = C_WIDTH + D_WIDTH
N_EVEN = (DEPTH + 1) // 2
N_ODD = DEPTH // 2
DN_ALPHA = (2 * DEPTH) ** 0.25
DN_BETA = (8 * DEPTH) ** -0.25
LN_EPS = 1e-5

kernel_name = "hybrid_gmlp_swa_rglru_pool_deepnorm"


def _split(h, sizes):
    idx = [int(i) for i in np.cumsum(sizes)[:-1]]
    return jnp.split(h, idx, axis=-1)


def layer_norm(x, g, b):
    xf = x.astype(jnp.float32)
    mu = jnp.mean(xf, axis=-1, keepdims=True)
    xc = xf - mu
    var = jnp.mean(xc * xc, axis=-1, keepdims=True)
    y = xc * lax.rsqrt(var + LN_EPS) * g.astype(jnp.float32) + b.astype(jnp.float32)
    return y.astype(x.dtype)


def partial_rope(t, cos, sin):
    half = ROT_DIM // 2
    t1, t2, rest = t[..., :half], t[..., half:ROT_DIM], t[..., ROT_DIM:]
    return jnp.concatenate([t1 * cos - t2 * sin, t2 * cos + t1 * sin, rest], axis=-1)


def chunked_gmlp(u, v, ln_g, ln_b, w_s, b_s):
    bsz, s, _ = v.shape
    nc = s // CHUNK
    v = layer_norm(v, ln_g, ln_b)
    vb = v.reshape(bsz, nc, CHUNK, A_GROUPS, A_GROUP_DIM)
    causal = jnp.tril(jnp.ones((CHUNK, CHUNK), dtype=bool))
    ws = jnp.where(causal[None], w_s, jnp.zeros_like(w_s))
    mixed = jnp.einsum('gts,bcsgd->bctgd', ws, vb) + b_s.T[None, None, :, :, None]
    return u * mixed.reshape(bsz, s, A_WIDTH)


def swa_with_sinks(q, k, v, sinks):
    bsz, s, hq, dh = q.shape
    grp = hq // B_KV_HEADS
    nb = s // WINDOW
    qb = q.reshape(bsz, nb, WINDOW, B_KV_HEADS, grp, dh)
    pad = ((0, 0), (1, 0), (0, 0), (0, 0), (0, 0))
    kb = k.reshape(bsz, nb, WINDOW, B_KV_HEADS, dh)
    vb = v.reshape(bsz, nb, WINDOW, B_KV_HEADS, dh)
    kband = jnp.concatenate([jnp.pad(kb[:, :-1], pad), kb], axis=2)
    vband = jnp.concatenate([jnp.pad(vb[:, :-1], pad), vb], axis=2)
    scores = jnp.einsum('bnqhgd,bnkhd->bnhgqk', qb, kband).astype(jnp.float32) * (dh ** -0.5)
    qi = jnp.arange(WINDOW)[:, None]
    kj = jnp.arange(2 * WINDOW)[None, :]
    diff = qi + WINDOW - kj
    band = (diff >= 0) & (diff < WINDOW)
    blk = jnp.arange(nb)[:, None, None]
    mask = band[None] & ((blk > 0) | (kj[None] >= WINDOW))
    scores = jnp.where(mask[None, :, None, None], scores, -jnp.inf)
    sink = jnp.broadcast_to(
        sinks.astype(jnp.float32).reshape(B_KV_HEADS, grp)[None, None, :, :, None, None],
        scores.shape[:-1] + (1,))
    probs = jax.nn.softmax(jnp.concatenate([scores, sink], axis=-1), axis=-1)[..., :-1]
    out = jnp.einsum('bnhgqk,bnkhd->bnqhgd', probs.astype(v.dtype), vband)
    return out.reshape(bsz, s, hq * dh)


def rg_lru(xc, conv_w, conv_b, w_a, b_a, w_x, b_x, lam):
    bsz, s, _ = xc.shape
    xconv = lax.conv_general_dilated(
        xc, conv_w[:, None, :], window_strides=(1,), padding=[(CONV_WIDTH - 1, 0)],
        dimension_numbers=('NWC', 'WIO', 'NWC'), feature_group_count=C_WIDTH) + conv_b
    xh = xconv.reshape(bsz, s, C_HEADS, C_HEAD_DIM)
    r = jax.nn.sigmoid(jnp.einsum('bshi,hij->bshj', xh, w_a).reshape(bsz, s, C_WIDTH) + b_a)
    i = jax.nn.sigmoid(jnp.einsum('bshi,hij->bshj', xh, w_x).reshape(bsz, s, C_WIDTH) + b_x)
    log_a = -LRU_C * r.astype(jnp.float32) * jax.nn.softplus(-lam.astype(jnp.float32))
    a = jnp.exp(log_a)
    mult = jnp.sqrt(-jnp.expm1(2.0 * log_a))
    bterm = mult * (i * xconv).astype(jnp.float32)

    def combine(left, right):
        a1, b1 = left
        a2, b2 = right
        return a1 * a2, a2 * b1 + b2

    _, h = lax.associative_scan(combine, (a, bterm), axis=1)
    return h.astype(xc.dtype)


def multiscale_pool(xd, w_pool, d_scale):
    bsz, s, _ = xd.shape
    xf = xd.astype(jnp.float32)
    csum = jnp.cumsum(xf, axis=1)
    pos1 = jnp.arange(s, dtype=jnp.float32)[None, :, None] + 1.0
    outs = []
    for g, w in enumerate(POOL_WINDOWS):
        sl = slice(g * D_GROUP_DIM, (g + 1) * D_GROUP_DIM)
        cg = csum[..., sl]
        shifted = jnp.pad(cg[:, :-w], ((0, 0), (w, 0), (0, 0)))
        mean = (cg - shifted) / jnp.minimum(pos1, float(w))
        outs.append(mean - xf[..., sl])
    pooled = jnp.stack(outs, axis=2).astype(xd.dtype)
    mixed = jnp.einsum('bsgi,gij->bsgj', pooled, w_pool).reshape(bsz, s, D_WIDTH)
    return mixed * d_scale


def even_layer(x, cos, sin, w_in, a_ln_g, a_ln_b, a_ws, a_bs, b_sinks, w_out, ln_g, ln_b):
    bsz, s, _ = x.shape
    h = x @ w_in
    u, v, a_gate, q, k, vv, b_gate = _split(h, EVEN_SIZES)
    a_out = chunked_gmlp(u, v, a_ln_g, a_ln_b, a_ws, a_bs) * jax.nn.silu(a_gate)
    q = partial_rope(q.reshape(bsz, s, B_Q_HEADS, B_HEAD_DIM), cos, sin)
    k = partial_rope(k.reshape(bsz, s, B_KV_HEADS, B_HEAD_DIM), cos, sin)
    vv = vv.reshape(bsz, s, B_KV_HEADS, B_HEAD_DIM)
    b_out = swa_with_sinks(q, k, vv, b_sinks) * jax.nn.silu(b_gate)
    y = jnp.concatenate([a_out, b_out], axis=-1) @ w_out
    return layer_norm(DN_ALPHA * x + y, ln_g, ln_b)


def odd_layer(x, w_in, conv_w, conv_b, w_a, b_a, w_x, b_x, lam, w_pool, d_scale,
              w_out, ln_g, ln_b):
    h = x @ w_in
    xc, c_gate, xd, d_gate = _split(h, ODD_SIZES)
    c_out = rg_lru(xc, conv_w, conv_b, w_a, b_a, w_x, b_x, lam) * jax.nn.silu(c_gate)
    d_out = multiscale_pool(xd, w_pool, d_scale) * jax.nn.silu(d_gate)
    y = jnp.concatenate([c_out, d_out], axis=-1) @ w_out
    return layer_norm(DN_ALPHA * x + y, ln_g, ln_b)


def setup_inputs(seed: int = 0) -> dict:
    key = jax.random.key(seed)
    ks = jax.random.split(key, 26)
    f32 = jnp.float32
    nrm = lambda k, shp, sc: sc * jax.random.normal(k, shp, f32)
    ne, no = N_EVEN, N_ODD
    u = jax.random.uniform(ks[25], (no, C_WIDTH), f32, 0.9, 0.999)
    a_base = u ** (1.0 / LRU_C)
    lam = jnp.log(a_base) - jnp.log1p(-a_base)
    return {
        "x": nrm(ks[0], (BATCH, SEQ, D_MODEL), 1.0),
        "positions": jnp.broadcast_to(jnp.arange(SEQ, dtype=jnp.int32)[None], (BATCH, SEQ)),
        "even_w_in": nrm(ks[1], (ne, D_MODEL, EVEN_IN), D_MODEL ** -0.5),
        "even_a_ln_g": 1.0 + nrm(ks[2], (ne, A_WIDTH), 0.01),
        "even_a_ln_b": nrm(ks[3], (ne, A_WIDTH), 0.01),
        "even_a_ws": nrm(ks[4], (ne, A_GROUPS, CHUNK, CHUNK), CHUNK ** -0.5),
        "even_a_bs": 1.0 + nrm(ks[5], (ne, A_GROUPS, CHUNK), 0.1),
        "even_b_sinks": nrm(ks[6], (ne, B_Q_HEADS), 0.5),
        "even_w_out": nrm(ks[7], (ne, EVEN_MIX, D_MODEL), DN_BETA * EVEN_MIX ** -0.5),
        "even_ln_g": 1.0 + nrm(ks[8], (ne, D_MODEL), 0.01),
        "even_ln_b": nrm(ks[9], (ne, D_MODEL), 0.01),
        "odd_w_in": nrm(ks[10], (no, D_MODEL, ODD_IN), D_MODEL ** -0.5),
        "odd_conv_w": nrm(ks[11], (no, CONV_WIDTH, C_WIDTH), CONV_WIDTH ** -0.5),
        "odd_conv_b": nrm(ks[12], (no, C_WIDTH), 0.01),
        "odd_w_a": nrm(ks[13], (no, C_HEADS, C_HEAD_DIM, C_HEAD_DIM), C_HEAD_DIM ** -0.5),
        "odd_b_a": nrm(ks[14], (no, C_WIDTH), 0.01),
        "odd_w_x": nrm(ks[15], (no, C_HEADS, C_HEAD_DIM, C_HEAD_DIM), C_HEAD_DIM ** -0.5),
        "odd_b_x": nrm(ks[16], (no, C_WIDTH), 0.01),
        "odd_lam": lam,
        "odd_w_pool": nrm(ks[17], (no, D_GROUPS, D_GROUP_DIM, D_GROUP_DIM), D_GROUP_DIM ** -0.5),
        "odd_d_scale": 1.0 + nrm(ks[18], (no, D_WIDTH), 0.1),
        "odd_w_out": nrm(ks[19], (no, ODD_MIX, D_MODEL), DN_BETA * ODD_MIX ** -0.5),
        "odd_ln_g": 1.0 + nrm(ks[20], (no, D_MODEL), 0.01),
        "odd_ln_b": nrm(ks[21], (no, D_MODEL), 0.01),
    }


def reference(x, positions, even_w_in, even_a_ln_g, even_a_ln_b, even_a_ws, even_a_bs,
              even_b_sinks, even_w_out, even_ln_g, even_ln_b, odd_w_in, odd_conv_w,
              odd_conv_b, odd_w_a, odd_b_a, odd_w_x, odd_b_x, odd_lam, odd_w_pool,
              odd_d_scale, odd_w_out, odd_ln_g, odd_ln_b):
    inv_freq = ROPE_THETA ** (-jnp.arange(0, ROT_DIM, 2, dtype=jnp.float32) / ROT_DIM)
    ang = positions.astype(jnp.float32)[..., None] * inv_freq
    cos = jnp.cos(ang)[:, :, None, :].astype(x.dtype)
    sin = jnp.sin(ang)[:, :, None, :].astype(x.dtype)
    for layer in range(DEPTH):
        j = layer // 2
        if layer % 2 == 0:
            x = even_layer(x, cos, sin, even_w_in[j], even_a_ln_g[j], even_a_ln_b[j],
                           even_a_ws[j], even_a_bs[j], even_b_sinks[j], even_w_out[j],
                           even_ln_g[j], even_ln_b[j])
        else:
            x = odd_layer(x, odd_w_in[j], odd_conv_w[j], odd_conv_b[j], odd_w_a[j],
                          odd_b_a[j], odd_w_x[j], odd_b_x[j], odd_lam[j], odd_w_pool[j],
                          odd_d_scale[j], odd_w_out[j], odd_ln_g[j], odd_ln_b[j])
    return x
```

```cpp
#include <hip/hip_runtime.h>
#include <hip/hip_cooperative_groups.h>
#include <cstdio>
#include <cmath>
#include <cstring>
namespace cg = cooperative_groups;
namespace pg8 {
#define PG8_LAS __attribute__((address_space(3)))
typedef unsigned short bf16_t;
typedef short bf16x8 __attribute__((ext_vector_type(8)));
typedef float f32x4 __attribute__((ext_vector_type(4)));
typedef unsigned u32x4 __attribute__((ext_vector_type(4)));
constexpr int BM = 256, BK = 64, HALF = 128, HTB = HALF * BK * 2  , STAGE_BYTES = 8 * HTB, NXCD = 8, WGM = 8;

__host__ __device__ __forceinline__ int lds_byte(int r, int c) { const int st = (r >> 4) * 2 + (c >> 5), rr = r & 15, cc = c & 31, ob = rr * 64 + cc * 2; return st * 1024 + (ob ^ (((ob >> 9) & 1) << 5)); }
__host__ __device__ __forceinline__ void stage_rc(int b, int& R, int& C) { const int st = b / 1024, sb = b % 1024, swz = sb ^ (((sb >> 9) & 1) << 5); R = (st >> 1) * 16 + swz / 64; C = (st & 1) * 32 + (swz % 64) / 2; }
__host__ __device__ __forceinline__ int perm32(int rho) { const int n = rho >> 4, i = rho & 15; return 8 * (i >> 2) + 4 * n + (i & 3); }

struct Unit { int pm, pn; };
struct Gemm { const bf16_t* A; const bf16_t* Bt; int M, N, K; };

struct StaticOrder {
    int nM, nN, nwg, G, c;
    __host__ __device__ void init(int M, int N, int G_, int c_) { nM = M / BM; nN = N / BM; nwg = nM * nN; G = G_; c = c_; }
    __host__ __device__ bool next(int i, Unit& u) const {
        const long L = (long)i * G + c; if (L >= nwg) return false;
        int wgid = (int)L; { const int q = nwg / NXCD, r = nwg % NXCD, xcd = wgid % NXCD, off = wgid / NXCD; wgid = (xcd < r ? xcd * (q + 1) : r * (q + 1) + (xcd - r) * q) + off; }
        const int nig = WGM * nN, gid = wgid / nig, fm = gid * WGM, gsz = (nM - fm) < WGM ? (nM - fm) : WGM;
        u.pm = fm + ((wgid % nig) % gsz); u.pn = (wgid % nig) / gsz; return true;
    }
    __device__ __forceinline__ void a_ready(const Unit&) const {}
    __device__ __forceinline__ void done(const Unit&) const {}
};
__device__ __forceinline__ unsigned cvt_pk_bf16(float lo, float hi) { unsigned r; asm volatile("v_cvt_pk_bf16_f32 %0, %1, %2" : "=v"(r) : "v"(lo), "v"(hi)); return r; }

template <class Epi, class Sched, bool STAMP = false>
__device__ __forceinline__ void gemm_phase(PG8_LAS unsigned char* lds, const Gemm g, const Sched& S, const Epi& E, unsigned long long* stamps) {
    int tid_ = threadIdx.x; asm volatile("" : "+v"(tid_));
    const int tid = tid_, wid = __builtin_amdgcn_readfirstlane(tid >> 6), lane = tid & 63, wr = wid >> 2, wc = wid & 3, fr = lane & 15, fq = lane >> 4;
    const int K = g.K, nt = K / BK;
    int ts_lo = 0, ts_hi = 0, nts = 0; const unsigned long long rt_entry = STAMP ? (unsigned long long)wall_clock64() : 0ull;
#define PG8_STAMP() do { if (STAMP && wid == 0 && nts < 64) { const unsigned long long _c = (unsigned long long)clock64(); \
        ts_lo = (lane == nts) ? (int)(unsigned)_c : ts_lo; ts_hi = (lane == nts) ? (int)(unsigned)(_c >> 32) : ts_hi; ++nts; } } while (0)
    PG8_STAMP();
    unsigned voffA[2], voffB[2];
#pragma unroll
    for (int i = 0; i < 2; ++i) { int R, C; stage_rc(tid * 16 + i * 8192, R, C); const int Rb = Epi::PERM ? ((R & ~31) + perm32(R & 31)) : R;
        voffA[i] = (unsigned)(R * K + C) * 2u; voffB[i] = (unsigned)(Rb * K + C) * 2u; }
    const size_t kstep = (size_t)(BK * 2);
    const size_t hstep = (size_t)HALF * K * 2;
    const size_t tstep = 2 * hstep;
    const unsigned ldsw = (unsigned)wid * 1024u;
    const int aoff = lds_byte(wr * 64 + fr, fq * 8), boff = lds_byte(wc * 32 + fr, fq * 8);
#define PG8_SA(b, h) (((b) * 2 + (h)) * HTB)
#define PG8_SB(b, h) ((4 + (b) * 2 + (h)) * HTB)
#define PG8_STAGE(bufoff, gbase, voff) do { _Pragma("unroll") for (int _i = 0; _i < 2; ++_i) \
        __builtin_amdgcn_global_load_lds((const unsigned*)((const char*)(gbase) + (voff)[_i]), (PG8_LAS unsigned*)(lds + (bufoff) + ldsw + _i * 8192), 16, 0, 0); } while (0)
#define PG8_LDA(dst, b, h) do { _Pragma("unroll") for (int m = 0; m < 4; ++m) _Pragma("unroll") for (int k = 0; k < 2; ++k) dst[m][k] = *(const PG8_LAS bf16x8*)(lds + PG8_SA(b, h) + aoff + m * 2048 + k * 1024); } while (0)
#define PG8_LDB(dst, b, h) do { _Pragma("unroll") for (int n = 0; n < 2; ++n) _Pragma("unroll") for (int k = 0; k < 2; ++k) dst[n][k] = *(const PG8_LAS bf16x8*)(lds + PG8_SB(b, h) + boff + n * 2048 + k * 1024); } while (0)
#define PG8_MMA(ai, bj, At, Bt) do { __builtin_amdgcn_s_setprio(1); _Pragma("unroll") for (int m = 0; m < 4; ++m) _Pragma("unroll") for (int n = 0; n < 2; ++n) _Pragma("unroll") for (int k = 0; k < 2; ++k) \
        acc[ai][bj][m][n] = __builtin_amdgcn_mfma_f32_16x16x32_bf16(Bt[n][k], At[m][k], acc[ai][bj][m][n], 0, 0, 0); __builtin_amdgcn_s_setprio(0); } while (0)
#define PG8_WAIT_V(n) asm volatile("s_waitcnt vmcnt(" #n ")" ::: "memory")
#define PG8_WAIT_L(n) asm volatile("s_waitcnt lgkmcnt(" #n ")" ::: "memory")
#define PG8_BAR __builtin_amdgcn_s_barrier()
#define PG8_SCHED __builtin_amdgcn_sched_barrier(0)
    Unit cur, nxt; int ui = 0;
    if (!S.next(0, cur)) return;
    f32x4 acc[2][2][4][2];
#pragma unroll
    for (int a = 0; a < 2; ++a)
#pragma unroll
        for (int b = 0; b < 2; ++b)
#pragma unroll
            for (int m = 0; m < 4; ++m)
#pragma unroll
                for (int n = 0; n < 2; ++n) acc[a][b][m][n] = (f32x4){0.f, 0.f, 0.f, 0.f};
    bf16x8 At[4][2], B0[2][2], B1[2][2];
    const char* cA = (const char*)g.A + (size_t)cur.pm * tstep; const char* cB = (const char*)g.Bt + (size_t)cur.pn * tstep;
    S.a_ready(cur);
    PG8_STAGE(PG8_SB(0, 0), cB, voffB); PG8_STAGE(PG8_SA(0, 0), cA, voffA); PG8_STAGE(PG8_SB(0, 1), cB + hstep, voffB); PG8_STAGE(PG8_SA(0, 1), cA + hstep, voffA);
    if (wr == 1) PG8_BAR;
    PG8_WAIT_V(4); PG8_BAR;
    PG8_STAGE(PG8_SB(1, 0), cB + kstep, voffB); PG8_STAGE(PG8_SA(1, 0), cA + kstep, voffA); PG8_STAGE(PG8_SB(1, 1), cB + hstep + kstep, voffB);
    PG8_WAIT_V(6); PG8_BAR;
    PG8_STAMP();
    for (;;) {
        const bool has_next = S.next(ui + 1, nxt);
        const char* nA = has_next ? (const char*)g.A + (size_t)nxt.pm * tstep : cA; const char* nB = has_next ? (const char*)g.Bt + (size_t)nxt.pn * tstep : cB;
        for (int t = 0; t < nt; t += 2) {
            const bool last = (t == nt - 2);
            const char* a1 = cA + (size_t)(t + 1) * kstep;
            const char* a2 = last ? nA : cA + (size_t)(t + 2) * kstep; const char* b2 = last ? nB : cB + (size_t)(t + 2) * kstep;
            const char* a3 = a2 + kstep; const char* b3 = b2 + kstep;
            if (last && has_next) S.a_ready(nxt);
            PG8_LDB(B0, 0, 0); PG8_SCHED; PG8_LDA(At, 0, 0); PG8_STAGE(PG8_SA(1, 1), a1 + hstep, voffA);
            PG8_WAIT_L(8); PG8_BAR; PG8_WAIT_L(0); PG8_MMA(0, 0, At, B0); PG8_BAR; PG8_SCHED;
            PG8_LDB(B1, 0, 1); PG8_STAGE(PG8_SB(0, 0), b2, voffB);
            PG8_BAR; PG8_WAIT_L(0); PG8_MMA(0, 1, At, B1); PG8_BAR;
            PG8_LDA(At, 0, 1); PG8_STAGE(PG8_SA(0, 0), a2, voffA);
            PG8_BAR; PG8_WAIT_L(0); PG8_MMA(1, 0, At, B0); PG8_BAR; PG8_SCHED;
            PG8_STAGE(PG8_SB(0, 1), b2 + hstep, voffB);
            PG8_WAIT_V(6); PG8_BAR; PG8_MMA(1, 1, At, B1); PG8_BAR;
            PG8_LDB(B0, 1, 0); PG8_SCHED; PG8_LDA(At, 1, 0); PG8_STAGE(PG8_SA(0, 1), a2 + hstep, voffA);
            PG8_WAIT_L(8); PG8_BAR; PG8_WAIT_L(0); PG8_MMA(0, 0, At, B0); PG8_BAR; PG8_SCHED;
            PG8_LDB(B1, 1, 1); PG8_STAGE(PG8_SB(1, 0), b3, voffB);
            PG8_BAR; PG8_WAIT_L(0); PG8_MMA(0, 1, At, B1); PG8_BAR;
            PG8_LDA(At, 1, 1); PG8_STAGE(PG8_SA(1, 0), a3, voffA);
            PG8_BAR; PG8_WAIT_L(0); PG8_MMA(1, 0, At, B0); PG8_BAR; PG8_SCHED;
            PG8_STAGE(PG8_SB(1, 1), b3 + hstep, voffB);
            PG8_WAIT_V(6); PG8_BAR; PG8_MMA(1, 1, At, B1); PG8_BAR;
        }
        PG8_STAMP();
        if constexpr (!Epi::AFTER_DRAIN) { E(acc, cur, wr, wc, fr, fq); S.done(cur); }
        PG8_STAMP();
        if (!has_next) break;
#pragma unroll
        for (int a = 0; a < 2; ++a)
#pragma unroll
            for (int b = 0; b < 2; ++b)
#pragma unroll
                for (int m = 0; m < 4; ++m)
#pragma unroll
                    for (int n = 0; n < 2; ++n) acc[a][b][m][n] = (f32x4){0.f, 0.f, 0.f, 0.f};
        cur = nxt; cA = nA; cB = nB; ++ui;
    }
    PG8_WAIT_V(0);
    if (wr == 0) PG8_BAR;
    PG8_BAR;
    if constexpr (Epi::AFTER_DRAIN) { E.fused(acc, cur, wr, wc, fr, fq, lds, wid, lane); S.done(cur); }
    PG8_STAMP();
    if (STAMP && wid == 0) { stamps[lane] = lane < nts ? (((unsigned long long)(unsigned)ts_hi << 32) | (unsigned)ts_lo) : 0ull;
        if (lane == 62) stamps[62] = rt_entry; if (lane == 63) stamps[63] = (unsigned long long)wall_clock64(); }
#undef PG8_STAMP
#undef PG8_SA
#undef PG8_SB
#undef PG8_STAGE
#undef PG8_LDA
#undef PG8_LDB
#undef PG8_MMA
#undef PG8_WAIT_V
#undef PG8_WAIT_L
#undef PG8_BAR
#undef PG8_SCHED
}
}

typedef unsigned short u16;
typedef float f4 __attribute__((ext_vector_type(4)));
typedef unsigned u4 __attribute__((ext_vector_type(4)));
typedef unsigned u2 __attribute__((ext_vector_type(2)));
constexpr int DM = 2048, NBATCH = 4, SEQ = 2048, NTOK = NBATCH * SEQ;
constexpr int EVEN_IN = 5376, ODD_IN = 4096;
constexpr int E_U = 0, E_V = 1024, E_AG = 2048, E_Q = 3072, E_K = 4096, E_VV = 4224, E_BG = 4352;
constexpr int O_XC = 0, O_CG = 1024, O_XD = 2048, O_DG = 3072;
constexpr float DN_ALPHA = 1.681792830507429f;
constexpr float LN_EPS = 1e-5f;

__device__ __forceinline__ float bf2f(u16 b) { return __uint_as_float(((unsigned)b) << 16); }
__device__ __forceinline__ u16 f2bf(float f) { unsigned u = __float_as_uint(f); u += 0x7FFFu + ((u >> 16) & 1u); return (u16)(u >> 16); }
__device__ __forceinline__ unsigned pack2(float lo, float hi) { return (unsigned)f2bf(lo) | ((unsigned)f2bf(hi) << 16); }
__device__ __forceinline__ float lo16(unsigned w) { return __uint_as_float(w << 16); }
__device__ __forceinline__ float hi16(unsigned w) { return __uint_as_float(w & 0xffff0000u); }
__device__ __forceinline__ float silu_f(float x) { return x / (1.0f + __expf(-x)); }
__device__ __forceinline__ float sigmoid_f(float x) { return 1.0f / (1.0f + __expf(-x)); }
__device__ __forceinline__ float wave_sum(float v) {
#pragma unroll
    for (int o = 32; o > 0; o >>= 1) v += __shfl_xor(v, o);
    return v;
}
__device__ __forceinline__ float wave_max(float v) {
#pragma unroll
    for (int o = 32; o > 0; o >>= 1) v = fmaxf(v, __shfl_xor(v, o));
    return v;
}

struct Params {
    const float* x; const int* positions;
    const float* even_w_in; const float* even_a_ln_g; const float* even_a_ln_b; const float* even_a_ws; const float* even_a_bs;
    const float* even_b_sinks; const float* even_w_out; const float* even_ln_g; const float* even_ln_b;
    const float* odd_w_in; const float* odd_conv_w; const float* odd_conv_b; const float* odd_w_a; const float* odd_b_a;
    const float* odd_w_x; const float* odd_b_x; const float* odd_lam; const float* odd_w_pool; const float* odd_d_scale;
    const float* odd_w_out; const float* odd_ln_g; const float* odd_ln_b;
    float* out;
    u16* wt_in;
    u16* wt_out;
    u16* xb;
    u16* h;
    u16* mix;
    float* rope;
    float* vstat;
    float* T0; float* T1; float* T2;
};

__device__ __forceinline__ void cvt_wT_tile(const float* __restrict__ W, u16* __restrict__ Wt, int K, int N, int tile, float* sm, int tid, int nthr) {
    const int ntn = N / 64; const int tk = tile / ntn, tn = tile % ntn;
    const float* src = W + (size_t)(tk * 64) * N + tn * 64;
    for (int i = tid; i < 64 * 16; i += nthr) { const int r = i >> 4, c4 = (i & 15) * 4; const f4 v = *(const f4*)(src + (size_t)r * N + c4);
        sm[r * 65 + c4] = v[0]; sm[r * 65 + c4 + 1] = v[1]; sm[r * 65 + c4 + 2] = v[2]; sm[r * 65 + c4 + 3] = v[3]; }
    __syncthreads();
    for (int i = tid; i < 64 * 8; i += nthr) { const int n = i & 63, k8 = (i >> 6) * 8;
        u4 w; w[0] = pack2(sm[(k8 + 0) * 65 + n], sm[(k8 + 1) * 65 + n]); w[1] = pack2(sm[(k8 + 2) * 65 + n], sm[(k8 + 3) * 65 + n]);
        w[2] = pack2(sm[(k8 + 4) * 65 + n], sm[(k8 + 5) * 65 + n]); w[3] = pack2(sm[(k8 + 6) * 65 + n], sm[(k8 + 7) * 65 + n]);
        *(u4*)(Wt + (size_t)(tn * 64 + n) * K + tk * 64 + k8) = w; }
    __syncthreads();
}
__device__ __forceinline__ void cvt_wT_all(const float* W, u16* Wt, int K, int N, float* sm, int bid, int nblk) {
    const int nt = (K / 64) * (N / 64);
    for (int t = bid; t < nt; t += nblk) cvt_wT_tile(W, Wt, K, N, t, sm, threadIdx.x, blockDim.x);
}

__device__ __forceinline__ void st_rope(const Params& p, int gt, int gn) {
    for (int i = gt; i < NTOK * 8; i += gn) { const int tok = i >> 3, f = i & 7;
        const float inv = exp2f(-(float)f * (18.931568569324174f / 8.0f));
        const float ang = (float)p.positions[tok] * inv;
        const double a = (double)ang; const double k = rint(a * 0.15915494309189535); const float r = (float)(a - k * 6.283185307179586);
        p.rope[tok * 16 + f] = __cosf(r); p.rope[tok * 16 + 8 + f] = __sinf(r); }
}
__device__ __forceinline__ void st_cvt_x(const float* __restrict__ x, u16* __restrict__ xb, int gt, int gn) {
    for (int i = gt; i < NTOK * DM / 4; i += gn) { const f4 v = ((const f4*)x)[i]; u2 w; w[0] = pack2(v[0], v[1]); w[1] = pack2(v[2], v[3]); ((u2*)xb)[i] = w; }
}

__device__ __forceinline__ void st_ln_rows(const float* z, const float* __restrict__ g, const float* __restrict__ b, float* xf, u16* __restrict__ xb, int gt, int gn) {
    const int lane = gt & 63; const int nw = gn >> 6;
    for (int row = gt >> 6; row < NTOK; row += nw) {
        f4 v[8]; float s = 0.f;
#pragma unroll
        for (int i = 0; i < 8; ++i) { v[i] = *(const f4*)(z + (size_t)row * DM + i * 256 + lane * 4); s += (v[i][0] + v[i][1]) + (v[i][2] + v[i][3]); }
        s = wave_sum(s); const float mu = s * (1.0f / DM); float q = 0.f;
#pragma unroll
        for (int i = 0; i < 8; ++i) { const f4 d = v[i] - mu; q += (d[0] * d[0] + d[1] * d[1]) + (d[2] * d[2] + d[3] * d[3]); }
        q = wave_sum(q); const float rstd = rsqrtf(q * (1.0f / DM) + LN_EPS);
#pragma unroll
        for (int i = 0; i < 8; ++i) { const int c = i * 256 + lane * 4; const f4 gg = *(const f4*)(g + c), bb = *(const f4*)(b + c);
            const f4 y = (v[i] - mu) * rstd * gg + bb; *(f4*)(xf + (size_t)row * DM + c) = y;
            u2 w; w[0] = pack2(y[0], y[1]); w[1] = pack2(y[2], y[3]); *(u2*)(xb + (size_t)row * DM + c) = w; }
    }
}

__device__ __forceinline__ void st_gmlp_stats(const Params& p, int gt, int gn) {
    const int lane = gt & 63; const int nw = gn >> 6;
    for (int tok = gt >> 6; tok < NTOK; tok += nw) {
        const u16* vp = p.h + (size_t)tok * EVEN_IN + E_V + lane * 16;
        float v[16]; const u4 a = *(const u4*)vp, b = *(const u4*)(vp + 8);
#pragma unroll
        for (int i = 0; i < 4; ++i) { v[2 * i] = lo16(a[i]); v[2 * i + 1] = hi16(a[i]); v[8 + 2 * i] = lo16(b[i]); v[8 + 2 * i + 1] = hi16(b[i]); }
        float s = 0.f;
#pragma unroll
        for (int i = 0; i < 16; ++i) s += v[i];
        s = wave_sum(s); const float mu = s * (1.0f / 1024.0f); float q = 0.f;
#pragma unroll
        for (int i = 0; i < 16; ++i) { const float d = v[i] - mu; q += d * d; }
        q = wave_sum(q);
        if (lane == 0) { p.vstat[tok * 2] = mu; p.vstat[tok * 2 + 1] = rsqrtf(q * (1.0f / 1024.0f) + LN_EPS); }
    }
}
__device__ __forceinline__ void st_gmlp_naive(const Params& p, int j, int gt, int gn) {
    const float* lng = p.even_a_ln_g + j * 1024; const float* lnb = p.even_a_ln_b + j * 1024;
    const float* ws = p.even_a_ws + (size_t)j * 8 * 128 * 128; const float* bs = p.even_a_bs + j * 8 * 128;
    for (int i = gt; i < NTOK * 1024; i += gn) { const int tok = i >> 10, c = i & 1023, g = c >> 7, tl = tok & 127, tok0 = tok - tl;
        float acc = bs[g * 128 + tl]; const float gg = lng[c], bb = lnb[c]; const float* wrow = ws + ((size_t)g * 128 + tl) * 128;
        for (int s = 0; s <= tl; ++s) { const float v = bf2f(p.h[(size_t)(tok0 + s) * EVEN_IN + E_V + c]);
            const float vl = (v - p.vstat[(tok0 + s) * 2]) * p.vstat[(tok0 + s) * 2 + 1] * gg + bb; acc += wrow[s] * vl; }
        const float u = bf2f(p.h[(size_t)tok * EVEN_IN + E_U + c]), ag = bf2f(p.h[(size_t)tok * EVEN_IN + E_AG + c]);
        p.mix[(size_t)tok * DM + c] = f2bf(u * acc * silu_f(ag)); }
}
__device__ __forceinline__ void st_attn_naive(const Params& p, int j, int gt, int gn) {
    const int lane = gt & 63; const int nw = gn >> 6;
    for (int item = gt >> 6; item < NTOK * 16; item += nw) { const int tok = item >> 4, hq = item & 15, hk = hq >> 3, tpos = tok & (SEQ - 1);
        float q[64]; const u16* qp = p.h + (size_t)tok * EVEN_IN + E_Q + hq * 64;
#pragma unroll
        for (int i = 0; i < 8; ++i) { const u4 w = *(const u4*)(qp + i * 8);
#pragma unroll
            for (int e = 0; e < 4; ++e) { q[i * 8 + 2 * e] = lo16(w[e]); q[i * 8 + 2 * e + 1] = hi16(w[e]); } }
        { const float* rp = p.rope + tok * 16;
#pragma unroll
          for (int f = 0; f < 8; ++f) { const float c = rp[f], s = rp[8 + f], t1 = q[f], t2 = q[8 + f]; q[f] = t1 * c - t2 * s; q[8 + f] = t2 * c + t1 * s; } }
        float sc[2];
#pragma unroll
        for (int half = 0; half < 2; ++half) { const int w = lane + half * 64; const int kp = tpos - w;
            float s = -INFINITY;
            if (kp >= 0) { const int kt = tok - w; const u16* kptr = p.h + (size_t)kt * EVEN_IN + E_K + hk * 64; const float* rp = p.rope + kt * 16; float kk[64];
#pragma unroll
                for (int i = 0; i < 8; ++i) { const u4 ww = *(const u4*)(kptr + i * 8);
#pragma unroll
                    for (int e = 0; e < 4; ++e) { kk[i * 8 + 2 * e] = lo16(ww[e]); kk[i * 8 + 2 * e + 1] = hi16(ww[e]); } }
#pragma unroll
                for (int f = 0; f < 8; ++f) { const float c = rp[f], sn = rp[8 + f], t1 = kk[f], t2 = kk[8 + f]; kk[f] = t1 * c - t2 * sn; kk[8 + f] = t2 * c + t1 * sn; }
                s = 0.f;
#pragma unroll
                for (int d = 0; d < 64; ++d) s += q[d] * kk[d];
                s *= 0.125f; }
            sc[half] = s; }
        const float sink = p.even_b_sinks[j * 16 + hq];
        const float m = fmaxf(wave_max(fmaxf(sc[0], sc[1])), sink);
        const float p0 = __expf(sc[0] - m), p1 = __expf(sc[1] - m);
        const float den = wave_sum(p0 + p1) + __expf(sink - m);
        float o = 0.f;
        for (int w = 0; w < 128; ++w) { const float pw = __shfl(w < 64 ? p0 : p1, w & 63); const int kp = tpos - w;
            if (kp >= 0) o += pw * bf2f(p.h[(size_t)(tok - w) * EVEN_IN + E_VV + hk * 64 + lane]); }
        const float bg = bf2f(p.h[(size_t)tok * EVEN_IN + E_BG + hq * 64 + lane]);
        p.mix[(size_t)tok * DM + 1024 + hq * 64 + lane] = f2bf(o / den * silu_f(bg)); }
}
__device__ __forceinline__ void st_lru_conv(const Params& p, int j, int gt, int gn) {
    const float* cw = p.odd_conv_w + j * 4 * 1024; const float* cb = p.odd_conv_b + j * 1024;
    for (int i = gt; i < NTOK * 1024; i += gn) { const int tok = i >> 10, c = i & 1023, tpos = tok & (SEQ - 1);
        float a = cb[c];
#pragma unroll
        for (int k = 0; k < 4; ++k) { const int d = 3 - k; if (tpos - d >= 0) a += cw[k * 1024 + c] * bf2f(p.h[(size_t)(tok - d) * ODD_IN + O_XC + c]); }
        p.T0[i] = a; }
}
__device__ __forceinline__ void st_lru_gates(const Params& p, int j, int gt, int gn) {
    const float* wa = p.odd_w_a + (size_t)j * 8 * 128 * 128; const float* wx = p.odd_w_x + (size_t)j * 8 * 128 * 128;
    for (int i = gt; i < NTOK * 1024; i += gn) { const int tok = i >> 10, c = i & 1023, hd = c >> 7, jj = c & 127;
        float ra = p.odd_b_a[j * 1024 + c], rx = p.odd_b_x[j * 1024 + c]; const float* xr = p.T0 + (size_t)tok * 1024 + hd * 128;
        for (int k = 0; k < 128; ++k) { const float xv = xr[k]; ra += xv * wa[((size_t)hd * 128 + k) * 128 + jj]; rx += xv * wx[((size_t)hd * 128 + k) * 128 + jj]; }
        const float r = sigmoid_f(ra), ig = sigmoid_f(rx); const float lam = p.odd_lam[j * 1024 + c];
        const float sp = log1pf(expf(-lam)); const float la = -8.0f * r * sp;
        p.T1[i] = expf(la); p.T2[i] = sqrtf(-expm1f(2.0f * la)) * (ig * p.T0[i]); }
}
__device__ __forceinline__ void st_lru_scan(const Params& p, int gt, int gn) {
    for (int i = gt; i < NBATCH * 1024; i += gn) { const int b = i >> 10, c = i & 1023; float hst = 0.f;
        for (int t = 0; t < SEQ; ++t) { const size_t tok = (size_t)b * SEQ + t; hst = p.T1[tok * 1024 + c] * hst + p.T2[tok * 1024 + c];
            p.mix[tok * DM + c] = f2bf(hst * silu_f(bf2f(p.h[tok * ODD_IN + O_CG + c]))); } }
}
__device__ __forceinline__ void st_pool_pre(const Params& p, int gt, int gn) {
    for (int i = gt; i < NTOK * 1024; i += gn) { const int tok = i >> 10, c = i & 1023, g = c >> 8, w = 2 << g, tpos = tok & (SEQ - 1);
        const int n = min(tpos + 1, w); float s = 0.f;
        for (int k = 0; k < n; ++k) s += bf2f(p.h[(size_t)(tok - k) * ODD_IN + O_XD + c]);
        p.T0[i] = s / (float)n - bf2f(p.h[(size_t)tok * ODD_IN + O_XD + c]); }
}
__device__ __forceinline__ void st_pool_mm(const Params& p, int j, int gt, int gn) {
    const float* wp = p.odd_w_pool + (size_t)j * 4 * 256 * 256;
    for (int i = gt; i < NTOK * 1024; i += gn) { const int tok = i >> 10, c = i & 1023, g = c >> 8, jj = c & 255;
        float a = 0.f; const float* pr = p.T0 + (size_t)tok * 1024 + g * 256;
        for (int k = 0; k < 256; ++k) a += pr[k] * wp[((size_t)g * 256 + k) * 256 + jj];
        a *= p.odd_d_scale[j * 1024 + c] * silu_f(bf2f(p.h[(size_t)tok * ODD_IN + O_DG + c]));
        p.mix[(size_t)tok * DM + 1024 + c] = f2bf(a); }
}

struct EpiH {
    static constexpr bool PERM = true, AFTER_DRAIN = false;
    u16* O; int ldc;
    __device__ __forceinline__ void operator()(const pg8::f32x4 (&acc)[2][2][4][2], const pg8::Unit& u, int wr, int wc, int fr, int fq) const {
        const int row0 = u.pm * 256 + wr * 64 + fr, col0 = u.pn * 256 + wc * 32 + 8 * fq;
#pragma unroll
        for (int ai = 0; ai < 2; ++ai)
#pragma unroll
            for (int m = 0; m < 4; ++m) { u16* rowp = O + (size_t)(row0 + ai * 128 + m * 16) * ldc + col0;
#pragma unroll
                for (int bj = 0; bj < 2; ++bj) { const pg8::f32x4 v0 = acc[ai][bj][m][0], v1 = acc[ai][bj][m][1];
                    u4 w; w[0] = pg8::cvt_pk_bf16(v0[0], v0[1]); w[1] = pg8::cvt_pk_bf16(v0[2], v0[3]); w[2] = pg8::cvt_pk_bf16(v1[0], v1[1]); w[3] = pg8::cvt_pk_bf16(v1[2], v1[3]);
                    *(u4*)(rowp + bj * 128) = w; } }
    }
};
struct EpiZ {
    static constexpr bool PERM = false, AFTER_DRAIN = false;
    const float* X; float* Z;
    __device__ __forceinline__ void operator()(const pg8::f32x4 (&acc)[2][2][4][2], const pg8::Unit& u, int wr, int wc, int fr, int fq) const {
        const int row0 = u.pm * 256 + wr * 64 + fr, col0 = u.pn * 256 + wc * 32 + 4 * fq;
#pragma unroll
        for (int ai = 0; ai < 2; ++ai)
#pragma unroll
            for (int m = 0; m < 4; ++m) { const size_t ro = (size_t)(row0 + ai * 128 + m * 16) * DM + col0;
#pragma unroll
                for (int bj = 0; bj < 2; ++bj)
#pragma unroll
                    for (int n = 0; n < 2; ++n) { const size_t o = ro + bj * 128 + n * 16; const pg8::f32x4 xv = *(const pg8::f32x4*)(X + o);
                        *(pg8::f32x4*)(Z + o) = xv * DN_ALPHA + acc[ai][bj][m][n]; } }
    }
};
#ifndef MK_ONE_LAUNCH
#define MK_ONE_LAUNCH 1
#endif

constexpr int NSLOT = 1 + 4 * 8;
constexpr int LDS_BYTES = 131072;
__host__ __device__ inline bool slot_used(int s) { if (s == 0) return true; const int layer = (s - 1) >> 3, k = (s - 1) & 7; return (layer & 1) ? (k < 7) : (k < 5); }

__device__ __forceinline__ void cvt_next_weights(const Params& p, int layer, float* sm, int bid_) {
    const int j = layer >> 1;
    const float* wo = (layer & 1) ? p.odd_w_out + (size_t)j * DM * DM : p.even_w_out + (size_t)j * DM * DM;
    cvt_wT_all(wo, p.wt_out, DM, DM, sm, bid_, gridDim.x);
    if (layer < 3) { const int nl = layer + 1, nj = nl >> 1;
        if (nl & 1) cvt_wT_all(p.odd_w_in + (size_t)nj * DM * ODD_IN, p.wt_in, DM, ODD_IN, sm, bid_, gridDim.x);
        else cvt_wT_all(p.even_w_in + (size_t)nj * DM * EVEN_IN, p.wt_in, DM, EVEN_IN, sm, bid_, gridDim.x); }
}

__device__ __forceinline__ void run_slot(const Params& p, int s, PG8_LAS unsigned char* lds, float* smf) {
    int tid_ = threadIdx.x; asm volatile("" : "+v"(tid_)); int bid_ = blockIdx.x; asm volatile("" : "+s"(bid_));
    const int gt = bid_ * 512 + tid_, gn = gridDim.x * 512;
    if (s == 0) { st_rope(p, gt, gn); st_cvt_x(p.x, p.xb, gt, gn); cvt_wT_all(p.even_w_in, p.wt_in, DM, EVEN_IN, smf, bid_, gridDim.x); return; }
    const int layer = (s - 1) >> 3, k = (s - 1) & 7, j = layer >> 1; const bool odd = layer & 1;
    const int gemm_z_slot = odd ? 5 : 3, ln_slot = odd ? 6 : 4;
    if (k == 0) { const int N = odd ? ODD_IN : EVEN_IN; pg8::Gemm g{p.xb, p.wt_in, NTOK, N, DM}; pg8::StaticOrder S; S.init(NTOK, N, gridDim.x, bid_);
        EpiH E{p.h, N}; pg8::gemm_phase<EpiH, pg8::StaticOrder, false>(lds, g, S, E, nullptr); return; }
    if (k == gemm_z_slot) { pg8::Gemm g{p.mix, p.wt_out, NTOK, DM, DM}; pg8::StaticOrder S; S.init(NTOK, DM, gridDim.x, bid_);
        EpiZ E{layer == 0 ? p.x : p.out, p.out}; pg8::gemm_phase<EpiZ, pg8::StaticOrder, false>(lds, g, S, E, nullptr); return; }
    if (k == ln_slot) { const float* g = odd ? p.odd_ln_g + j * DM : p.even_ln_g + j * DM; const float* b = odd ? p.odd_ln_b + j * DM : p.even_ln_b + j * DM;
        st_ln_rows(p.out, g, b, p.out, p.xb, gt, gn); return; }
    if (!odd) {
        if (k == 1) { st_gmlp_stats(p, gt, gn); cvt_next_weights(p, layer, smf, bid_); }
        else if (k == 2) { st_gmlp_naive(p, j, gt, gn); st_attn_naive(p, j, gt, gn); }
    } else {
        if (k == 1) { st_lru_conv(p, j, gt, gn); cvt_next_weights(p, layer, smf, bid_); }
        else if (k == 2) st_lru_gates(p, j, gt, gn);
        else if (k == 3) { st_lru_scan(p, gt, gn); st_pool_pre(p, gt, gn); }
        else if (k == 4) st_pool_mm(p, j, gt, gn);
    }
}

struct KArgs { Params p; int lo, hi; };
__global__ void __launch_bounds__(512, 2) k_mega(KArgs a) {
    extern __shared__ __attribute__((aligned(16))) unsigned char shm[];
    cg::grid_group grid = cg::this_grid();
    for (int s = a.lo; s < a.hi; ++s) {
        if (!slot_used(s)) continue;
        run_slot(a.p, s, (PG8_LAS unsigned char*)shm, (float*)shm);
        if (s + 1 < a.hi) grid.sync();
    }
}

extern "C" void kernel_launch(void* const* d_in, const int* in_sizes, int n_in, void* d_out, int out_size, void* d_ws, size_t ws_size, hipStream_t stream) {
    static int grid = 0;
    if (grid == 0) {
        int dev = 0, cus = 0, per_cu = 0;
        hipGetDevice(&dev); hipDeviceGetAttribute(&cus, hipDeviceAttributeMultiprocessorCount, dev);
        if (hipFuncSetAttribute((const void*)k_mega, hipFuncAttributeMaxDynamicSharedMemorySize, LDS_BYTES) != hipSuccess) { fprintf(stderr, "hipFuncSetAttribute failed\n"); grid = -1; return; }
        hipOccupancyMaxActiveBlocksPerMultiprocessor(&per_cu, (const void*)k_mega, 512, LDS_BYTES);
        if (per_cu < 1) { fprintf(stderr, "occupancy query says %d\n", per_cu); per_cu = 1; }
        (void)hipGetLastError();
        grid = cus;
    }
    if (grid < 0) return;
    KArgs a; memset(&a, 0, sizeof(a));
    Params& p = a.p;
    p.x = (const float*)d_in[0]; p.positions = (const int*)d_in[1];
    p.even_w_in = (const float*)d_in[2]; p.even_a_ln_g = (const float*)d_in[3]; p.even_a_ln_b = (const float*)d_in[4]; p.even_a_ws = (const float*)d_in[5];
    p.even_a_bs = (const float*)d_in[6]; p.even_b_sinks = (const float*)d_in[7]; p.even_w_out = (const float*)d_in[8]; p.even_ln_g = (const float*)d_in[9];
    p.even_ln_b = (const float*)d_in[10]; p.odd_w_in = (const float*)d_in[11]; p.odd_conv_w = (const float*)d_in[12]; p.odd_conv_b = (const float*)d_in[13];
    p.odd_w_a = (const float*)d_in[14]; p.odd_b_a = (const float*)d_in[15]; p.odd_w_x = (const float*)d_in[16]; p.odd_b_x = (const float*)d_in[17];
    p.odd_lam = (const float*)d_in[18]; p.odd_w_pool = (const float*)d_in[19]; p.odd_d_scale = (const float*)d_in[20]; p.odd_w_out = (const float*)d_in[21];
    p.odd_ln_g = (const float*)d_in[22]; p.odd_ln_b = (const float*)d_in[23];
    p.out = (float*)d_out;
    unsigned char* w = (unsigned char*)d_ws; size_t off = 0;
    auto take = [&](size_t bytes) { unsigned char* r = w + off; off += (bytes + 255) & ~(size_t)255; return r; };
    p.wt_in = (u16*)take((size_t)EVEN_IN * DM * 2); p.wt_out = (u16*)take((size_t)DM * DM * 2); p.xb = (u16*)take((size_t)NTOK * DM * 2);
    p.h = (u16*)take((size_t)NTOK * EVEN_IN * 2); p.mix = (u16*)take((size_t)NTOK * DM * 2); p.rope = (float*)take((size_t)NTOK * 16 * 4);
    p.vstat = (float*)take((size_t)NTOK * 2 * 4);
    p.T0 = (float*)take((size_t)NTOK * 1024 * 4); p.T1 = (float*)take((size_t)NTOK * 1024 * 4); p.T2 = (float*)take((size_t)NTOK * 1024 * 4);
    if (off > ws_size) { fprintf(stderr, "workspace too small: need %zu have %zu\n", off, ws_size); return; }
#if MK_ONE_LAUNCH
    a.lo = 0; a.hi = NSLOT; void* args[] = {&a};
    hipError_t e = hipLaunchCooperativeKernel((const void*)k_mega, dim3(grid), dim3(512), args, LDS_BYTES, stream);
    if (e != hipSuccess) fprintf(stderr, "cooperative launch failed: %s (grid %d)\n", hipGetErrorString(e), grid);
#else
    for (int s = 0; s < NSLOT; ++s) { if (!slot_used(s)) continue; a.lo = s; a.hi = s + 1;
        hipLaunchKernelGGL(k_mega, dim3(grid), dim3(512), LDS_BYTES, stream, a); }
#endif
}
```

```cpp
#include <hip/hip_runtime.h>
#include <hip/hip_cooperative_groups.h>
#include <cstdio>
#include <cmath>
#include <cstring>
namespace cg = cooperative_groups;
namespace pg8 {
#define PG8_LAS __attribute__((address_space(3)))
typedef unsigned short bf16_t;
typedef short bf16x8 __attribute__((ext_vector_type(8)));
typedef float f32x4 __attribute__((ext_vector_type(4)));
typedef unsigned u32x4 __attribute__((ext_vector_type(4)));
constexpr int BM = 256, BK = 64, HALF = 128, HTB = HALF * BK * 2  , STAGE_BYTES = 8 * HTB, NXCD = 8, WGM = 8;

__host__ __device__ __forceinline__ int lds_byte(int r, int c) { const int st = (r >> 4) * 2 + (c >> 5), rr = r & 15, cc = c & 31, ob = rr * 64 + cc * 2; return st * 1024 + (ob ^ (((ob >> 9) & 1) << 5)); }
__host__ __device__ __forceinline__ void stage_rc(int b, int& R, int& C) { const int st = b / 1024, sb = b % 1024, swz = sb ^ (((sb >> 9) & 1) << 5); R = (st >> 1) * 16 + swz / 64; C = (st & 1) * 32 + (swz % 64) / 2; }
__host__ __device__ __forceinline__ int perm32(int rho) { const int n = rho >> 4, i = rho & 15; return 8 * (i >> 2) + 4 * n + (i & 3); }

struct Unit { int pm, pn; };
struct Gemm { const bf16_t* A; const bf16_t* Bt; int M, N, K; };

struct StaticOrder {
    int nM, nN, nwg, G, c;
    __host__ __device__ void init(int M, int N, int G_, int c_) { nM = M / BM; nN = N / BM; nwg = nM * nN; G = G_; c = c_; }
    __host__ __device__ bool next(int i, Unit& u) const {
        const long L = (long)i * G + c; if (L >= nwg) return false;
        int wgid = (int)L; { const int q = nwg / NXCD, r = nwg % NXCD, xcd = wgid % NXCD, off = wgid / NXCD; wgid = (xcd < r ? xcd * (q + 1) : r * (q + 1) + (xcd - r) * q) + off; }
        const int nig = WGM * nN, gid = wgid / nig, fm = gid * WGM, gsz = (nM - fm) < WGM ? (nM - fm) : WGM;
        u.pm = fm + ((wgid % nig) % gsz); u.pn = (wgid % nig) / gsz; return true;
    }
    __device__ __forceinline__ void a_ready(const Unit&) const {}
    __device__ __forceinline__ void done(const Unit&) const {}
};
__device__ __forceinline__ unsigned cvt_pk_bf16(float lo, float hi) { unsigned r; asm volatile("v_cvt_pk_bf16_f32 %0, %1, %2" : "=v"(r) : "v"(lo), "v"(hi)); return r; }

template <class Epi, class Sched, bool STAMP = false>
__device__ __forceinline__ void gemm_phase(PG8_LAS unsigned char* lds, const Gemm g, const Sched& S, const Epi& E, unsigned long long* stamps) {
    int tid_ = threadIdx.x; asm volatile("" : "+v"(tid_));
    const int tid = tid_, wid = __builtin_amdgcn_readfirstlane(tid >> 6), lane = tid & 63, wr = wid >> 2, wc = wid & 3, fr = lane & 15, fq = lane >> 4;
    const int K = g.K, nt = K / BK;
    int ts_lo = 0, ts_hi = 0, nts = 0; const unsigned long long rt_entry = STAMP ? (unsigned long long)wall_clock64() : 0ull;
#define PG8_STAMP() do { if (STAMP && wid == 0 && nts < 64) { const unsigned long long _c = (unsigned long long)clock64(); \
        ts_lo = (lane == nts) ? (int)(unsigned)_c : ts_lo; ts_hi = (lane == nts) ? (int)(unsigned)(_c >> 32) : ts_hi; ++nts; } } while (0)
    PG8_STAMP();
    unsigned voffA[2], voffB[2];
#pragma unroll
    for (int i = 0; i < 2; ++i) { int R, C; stage_rc(tid * 16 + i * 8192, R, C); const int Rb = Epi::PERM ? ((R & ~31) + perm32(R & 31)) : R;
        voffA[i] = (unsigned)(R * K + C) * 2u; voffB[i] = (unsigned)(Rb * K + C) * 2u; }
    const size_t kstep = (size_t)(BK * 2);
    const size_t hstep = (size_t)HALF * K * 2;
    const size_t tstep = 2 * hstep;
    const unsigned ldsw = (unsigned)wid * 1024u;
    const int aoff = lds_byte(wr * 64 + fr, fq * 8), boff = lds_byte(wc * 32 + fr, fq * 8);
#define PG8_SA(b, h) (((b) * 2 + (h)) * HTB)
#define PG8_SB(b, h) ((4 + (b) * 2 + (h)) * HTB)
#define PG8_STAGE(bufoff, gbase, voff) do { _Pragma("unroll") for (int _i = 0; _i < 2; ++_i) \
        __builtin_amdgcn_global_load_lds((const unsigned*)((const char*)(gbase) + (voff)[_i]), (PG8_LAS unsigned*)(lds + (bufoff) + ldsw + _i * 8192), 16, 0, 0); } while (0)
#define PG8_LDA(dst, b, h) do { _Pragma("unroll") for (int m = 0; m < 4; ++m) _Pragma("unroll") for (int k = 0; k < 2; ++k) dst[m][k] = *(const PG8_LAS bf16x8*)(lds + PG8_SA(b, h) + aoff + m * 2048 + k * 1024); } while (0)
#define PG8_LDB(dst, b, h) do { _Pragma("unroll") for (int n = 0; n < 2; ++n) _Pragma("unroll") for (int k = 0; k < 2; ++k) dst[n][k] = *(const PG8_LAS bf16x8*)(lds + PG8_SB(b, h) + boff + n * 2048 + k * 1024); } while (0)
#define PG8_MMA(ai, bj, At, Bt) do { __builtin_amdgcn_s_setprio(1); _Pragma("unroll") for (int m = 0; m < 4; ++m) _Pragma("unroll") for (int n = 0; n < 2; ++n) _Pragma("unroll") for (int k = 0; k < 2; ++k) \
        acc[ai][bj][m][n] = __builtin_amdgcn_mfma_f32_16x16x32_bf16(Bt[n][k], At[m][k], acc[ai][bj][m][n], 0, 0, 0); __builtin_amdgcn_s_setprio(0); } while (0)
#define PG8_WAIT_V(n) asm volatile("s_waitcnt vmcnt(" #n ")" ::: "memory")
#define PG8_WAIT_L(n) asm volatile("s_waitcnt lgkmcnt(" #n ")" ::: "memory")
#define PG8_BAR __builtin_amdgcn_s_barrier()
#define PG8_SCHED __builtin_amdgcn_sched_barrier(0)
    Unit cur, nxt; int ui = 0;
    if (!S.next(0, cur)) return;
    f32x4 acc[2][2][4][2];
#pragma unroll
    for (int a = 0; a < 2; ++a)
#pragma unroll
        for (int b = 0; b < 2; ++b)
#pragma unroll
            for (int m = 0; m < 4; ++m)
#pragma unroll
                for (int n = 0; n < 2; ++n) acc[a][b][m][n] = (f32x4){0.f, 0.f, 0.f, 0.f};
    bf16x8 At[4][2], B0[2][2], B1[2][2];
    const char* cA = (const char*)g.A + (size_t)cur.pm * tstep; const char* cB = (const char*)g.Bt + (size_t)cur.pn * tstep;
    S.a_ready(cur);
    PG8_STAGE(PG8_SB(0, 0), cB, voffB); PG8_STAGE(PG8_SA(0, 0), cA, voffA); PG8_STAGE(PG8_SB(0, 1), cB + hstep, voffB); PG8_STAGE(PG8_SA(0, 1), cA + hstep, voffA);
    if (wr == 1) PG8_BAR;
    PG8_WAIT_V(4); PG8_BAR;
    PG8_STAGE(PG8_SB(1, 0), cB + kstep, voffB); PG8_STAGE(PG8_SA(1, 0), cA + kstep, voffA); PG8_STAGE(PG8_SB(1, 1), cB + hstep + kstep, voffB);
    PG8_WAIT_V(6); PG8_BAR;
    PG8_STAMP();
    for (;;) {
        const bool has_next = S.next(ui + 1, nxt);
        const char* nA = has_next ? (const char*)g.A + (size_t)nxt.pm * tstep : cA; const char* nB = has_next ? (const char*)g.Bt + (size_t)nxt.pn * tstep : cB;
        for (int t = 0; t < nt; t += 2) {
            const bool last = (t == nt - 2);
            const char* a1 = cA + (size_t)(t + 1) * kstep;
            const char* a2 = last ? nA : cA + (size_t)(t + 2) * kstep; const char* b2 = last ? nB : cB + (size_t)(t + 2) * kstep;
            const char* a3 = a2 + kstep; const char* b3 = b2 + kstep;
            if (last && has_next) S.a_ready(nxt);
            PG8_LDB(B0, 0, 0); PG8_SCHED; PG8_LDA(At, 0, 0); PG8_STAGE(PG8_SA(1, 1), a1 + hstep, voffA);
            PG8_WAIT_L(8); PG8_BAR; PG8_WAIT_L(0); PG8_MMA(0, 0, At, B0); PG8_BAR; PG8_SCHED;
            PG8_LDB(B1, 0, 1); PG8_STAGE(PG8_SB(0, 0), b2, voffB);
            PG8_BAR; PG8_WAIT_L(0); PG8_MMA(0, 1, At, B1); PG8_BAR;
            PG8_LDA(At, 0, 1); PG8_STAGE(PG8_SA(0, 0), a2, voffA);
            PG8_BAR; PG8_WAIT_L(0); PG8_MMA(1, 0, At, B0); PG8_BAR; PG8_SCHED;
            PG8_STAGE(PG8_SB(0, 1), b2 + hstep, voffB);
            PG8_WAIT_V(6); PG8_BAR; PG8_MMA(1, 1, At, B1); PG8_BAR;
            PG8_LDB(B0, 1, 0); PG8_SCHED; PG8_LDA(At, 1, 0); PG8_STAGE(PG8_SA(0, 1), a2 + hstep, voffA);
            PG8_WAIT_L(8); PG8_BAR; PG8_WAIT_L(0); PG8_MMA(0, 0, At, B0); PG8_BAR; PG8_SCHED;
            PG8_LDB(B1, 1, 1); PG8_STAGE(PG8_SB(1, 0), b3, voffB);
            PG8_BAR; PG8_WAIT_L(0); PG8_MMA(0, 1, At, B1); PG8_BAR;
            PG8_LDA(At, 1, 1); PG8_STAGE(PG8_SA(1, 0), a3, voffA);
            PG8_BAR; PG8_WAIT_L(0); PG8_MMA(1, 0, At, B0); PG8_BAR; PG8_SCHED;
            PG8_STAGE(PG8_SB(1, 1), b3 + hstep, voffB);
            PG8_WAIT_V(6); PG8_BAR; PG8_MMA(1, 1, At, B1); PG8_BAR;
        }
        PG8_STAMP();
        if constexpr (!Epi::AFTER_DRAIN) { E(acc, cur, wr, wc, fr, fq); S.done(cur); }
        PG8_STAMP();
        if (!has_next) break;
#pragma unroll
        for (int a = 0; a < 2; ++a)
#pragma unroll
            for (int b = 0; b < 2; ++b)
#pragma unroll
                for (int m = 0; m < 4; ++m)
#pragma unroll
                    for (int n = 0; n < 2; ++n) acc[a][b][m][n] = (f32x4){0.f, 0.f, 0.f, 0.f};
        cur = nxt; cA = nA; cB = nB; ++ui;
    }
    PG8_WAIT_V(0);
    if (wr == 0) PG8_BAR;
    PG8_BAR;
    if constexpr (Epi::AFTER_DRAIN) { E.fused(acc, cur, wr, wc, fr, fq, lds, wid, lane); S.done(cur); }
    PG8_STAMP();
    if (STAMP && wid == 0) { stamps[lane] = lane < nts ? (((unsigned long long)(unsigned)ts_hi << 32) | (unsigned)ts_lo) : 0ull;
        if (lane == 62) stamps[62] = rt_entry; if (lane == 63) stamps[63] = (unsigned long long)wall_clock64(); }
#undef PG8_STAMP
#undef PG8_SA
#undef PG8_SB
#undef PG8_STAGE
#undef PG8_LDA
#undef PG8_LDB
#undef PG8_MMA
#undef PG8_WAIT_V
#undef PG8_WAIT_L
#undef PG8_BAR
#undef PG8_SCHED
}
}

typedef unsigned short u16;
typedef float f4 __attribute__((ext_vector_type(4)));
typedef unsigned u4 __attribute__((ext_vector_type(4)));
typedef unsigned u2 __attribute__((ext_vector_type(2)));
constexpr int DM = 2048, NBATCH = 4, SEQ = 2048, NTOK = NBATCH * SEQ;
constexpr int EVEN_IN = 5376, ODD_IN = 4096;
constexpr int E_U = 0, E_V = 1024, E_AG = 2048, E_Q = 3072, E_K = 4096, E_VV = 4224, E_BG = 4352;
constexpr int O_XC = 0, O_CG = 1024, O_XD = 2048, O_DG = 3072;
constexpr float DN_ALPHA = 1.681792830507429f;
constexpr float LN_EPS = 1e-5f;

__device__ __forceinline__ float bf2f(u16 b) { return __uint_as_float(((unsigned)b) << 16); }
__device__ __forceinline__ u16 f2bf(float f) { unsigned u = __float_as_uint(f); u += 0x7FFFu + ((u >> 16) & 1u); return (u16)(u >> 16); }
__device__ __forceinline__ unsigned pack2(float lo, float hi) { return (unsigned)f2bf(lo) | ((unsigned)f2bf(hi) << 16); }
__device__ __forceinline__ float lo16(unsigned w) { return __uint_as_float(w << 16); }
__device__ __forceinline__ float hi16(unsigned w) { return __uint_as_float(w & 0xffff0000u); }
__device__ __forceinline__ float silu_f(float x) { return x / (1.0f + __expf(-x)); }
__device__ __forceinline__ float sigmoid_f(float x) { return 1.0f / (1.0f + __expf(-x)); }
__device__ __forceinline__ float wave_sum(float v) {
#pragma unroll
    for (int o = 32; o > 0; o >>= 1) v += __shfl_xor(v, o);
    return v;
}
__device__ __forceinline__ float wave_max(float v) {
#pragma unroll
    for (int o = 32; o > 0; o >>= 1) v = fmaxf(v, __shfl_xor(v, o));
    return v;
}

struct Params {
    const float* x; const int* positions;
    const float* even_w_in; const float* even_a_ln_g; const float* even_a_ln_b; const float* even_a_ws; const float* even_a_bs;
    const float* even_b_sinks; const float* even_w_out; const float* even_ln_g; const float* even_ln_b;
    const float* odd_w_in; const float* odd_conv_w; const float* odd_conv_b; const float* odd_w_a; const float* odd_b_a;
    const float* odd_w_x; const float* odd_b_x; const float* odd_lam; const float* odd_w_pool; const float* odd_d_scale;
    const float* odd_w_out; const float* odd_ln_g; const float* odd_ln_b;
    float* out;
    u16* wt_in;
    u16* wt_out;
    u16* xb;
    u16* h;
    u16* mix;
    float* rope;
    float* vstat;
    u16* wpT;
    float* T0; float* T1; float* T2;
};

__device__ __forceinline__ void cvt_wT_tile(const float* __restrict__ W, u16* __restrict__ Wt, int K, int N, int tile, float* sm, int tid, int nthr) {
    const int ntn = N / 64; const int tk = tile / ntn, tn = tile % ntn;
    const float* src = W + (size_t)(tk * 64) * N + tn * 64;
    for (int i = tid; i < 64 * 16; i += nthr) { const int r = i >> 4, c4 = (i & 15) * 4; const f4 v = *(const f4*)(src + (size_t)r * N + c4);
        sm[r * 65 + c4] = v[0]; sm[r * 65 + c4 + 1] = v[1]; sm[r * 65 + c4 + 2] = v[2]; sm[r * 65 + c4 + 3] = v[3]; }
    __syncthreads();
    for (int i = tid; i < 64 * 8; i += nthr) { const int n = i & 63, k8 = (i >> 6) * 8;
        u4 w; w[0] = pack2(sm[(k8 + 0) * 65 + n], sm[(k8 + 1) * 65 + n]); w[1] = pack2(sm[(k8 + 2) * 65 + n], sm[(k8 + 3) * 65 + n]);
        w[2] = pack2(sm[(k8 + 4) * 65 + n], sm[(k8 + 5) * 65 + n]); w[3] = pack2(sm[(k8 + 6) * 65 + n], sm[(k8 + 7) * 65 + n]);
        *(u4*)(Wt + (size_t)(tn * 64 + n) * K + tk * 64 + k8) = w; }
    __syncthreads();
}
__device__ __forceinline__ void cvt_wT_all(const float* W, u16* Wt, int K, int N, float* sm, int bid, int nblk) {
    const int nt = (K / 64) * (N / 64);
    for (int t = bid; t < nt; t += nblk) cvt_wT_tile(W, Wt, K, N, t, sm, threadIdx.x, blockDim.x);
}

__device__ __forceinline__ void st_rope(const Params& p, int gt, int gn) {
    for (int i = gt; i < NTOK * 8; i += gn) { const int tok = i >> 3, f = i & 7;
        const float inv = exp2f(-(float)f * (18.931568569324174f / 8.0f));
        const float ang = (float)p.positions[tok] * inv;
        const double a = (double)ang; const double k = rint(a * 0.15915494309189535); const float r = (float)(a - k * 6.283185307179586);
        p.rope[tok * 16 + f] = __cosf(r); p.rope[tok * 16 + 8 + f] = __sinf(r); }
}
__device__ __forceinline__ void st_cvt_x(const float* __restrict__ x, u16* __restrict__ xb, int gt, int gn) {
    for (int i = gt; i < NTOK * DM / 4; i += gn) { const f4 v = ((const f4*)x)[i]; u2 w; w[0] = pack2(v[0], v[1]); w[1] = pack2(v[2], v[3]); ((u2*)xb)[i] = w; }
}

__device__ __forceinline__ void st_ln_rows(const float* z, const float* __restrict__ g, const float* __restrict__ b, float* xf, u16* __restrict__ xb, int gt, int gn) {
    const int lane = gt & 63; const int nw = gn >> 6;
    for (int row = gt >> 6; row < NTOK; row += nw) {
        f4 v[8]; float s = 0.f;
#pragma unroll
        for (int i = 0; i < 8; ++i) { v[i] = *(const f4*)(z + (size_t)row * DM + i * 256 + lane * 4); s += (v[i][0] + v[i][1]) + (v[i][2] + v[i][3]); }
        s = wave_sum(s); const float mu = s * (1.0f / DM); float q = 0.f;
#pragma unroll
        for (int i = 0; i < 8; ++i) { const f4 d = v[i] - mu; q += (d[0] * d[0] + d[1] * d[1]) + (d[2] * d[2] + d[3] * d[3]); }
        q = wave_sum(q); const float rstd = rsqrtf(q * (1.0f / DM) + LN_EPS);
#pragma unroll
        for (int i = 0; i < 8; ++i) { const int c = i * 256 + lane * 4; const f4 gg = *(const f4*)(g + c), bb = *(const f4*)(b + c);
            const f4 y = (v[i] - mu) * rstd * gg + bb; *(f4*)(xf + (size_t)row * DM + c) = y;
            u2 w; w[0] = pack2(y[0], y[1]); w[1] = pack2(y[2], y[3]); *(u2*)(xb + (size_t)row * DM + c) = w; }
    }
}

__device__ __forceinline__ void st_gmlp_stats(const Params& p, int gt, int gn) {
    const int lane = gt & 63; const int nw = gn >> 6;
    for (int tok = gt >> 6; tok < NTOK; tok += nw) {
        const u16* vp = p.h + (size_t)tok * EVEN_IN + E_V + lane * 16;
        float v[16]; const u4 a = *(const u4*)vp, b = *(const u4*)(vp + 8);
#pragma unroll
        for (int i = 0; i < 4; ++i) { v[2 * i] = lo16(a[i]); v[2 * i + 1] = hi16(a[i]); v[8 + 2 * i] = lo16(b[i]); v[8 + 2 * i + 1] = hi16(b[i]); }
        float s = 0.f;
#pragma unroll
        for (int i = 0; i < 16; ++i) s += v[i];
        s = wave_sum(s); const float mu = s * (1.0f / 1024.0f); float q = 0.f;
#pragma unroll
        for (int i = 0; i < 16; ++i) { const float d = v[i] - mu; q += d * d; }
        q = wave_sum(q);
        if (lane == 0) { p.vstat[tok * 2] = mu; p.vstat[tok * 2 + 1] = rsqrtf(q * (1.0f / 1024.0f) + LN_EPS); }
    }
}
__device__ __forceinline__ void st_gmlp_naive(const Params& p, int j, int gt, int gn) {
    const float* lng = p.even_a_ln_g + j * 1024; const float* lnb = p.even_a_ln_b + j * 1024;
    const float* ws = p.even_a_ws + (size_t)j * 8 * 128 * 128; const float* bs = p.even_a_bs + j * 8 * 128;
    for (int i = gt; i < NTOK * 1024; i += gn) { const int tok = i >> 10, c = i & 1023, g = c >> 7, tl = tok & 127, tok0 = tok - tl;
        float acc = bs[g * 128 + tl]; const float gg = lng[c], bb = lnb[c]; const float* wrow = ws + ((size_t)g * 128 + tl) * 128;
        for (int s = 0; s <= tl; ++s) { const float v = bf2f(p.h[(size_t)(tok0 + s) * EVEN_IN + E_V + c]);
            const float vl = (v - p.vstat[(tok0 + s) * 2]) * p.vstat[(tok0 + s) * 2 + 1] * gg + bb; acc += wrow[s] * vl; }
        const float u = bf2f(p.h[(size_t)tok * EVEN_IN + E_U + c]), ag = bf2f(p.h[(size_t)tok * EVEN_IN + E_AG + c]);
        p.mix[(size_t)tok * DM + c] = f2bf(u * acc * silu_f(ag)); }
}
__device__ __forceinline__ void st_attn_naive(const Params& p, int j, int gt, int gn) {
    const int lane = gt & 63; const int nw = gn >> 6;
    for (int item = gt >> 6; item < NTOK * 16; item += nw) { const int tok = item >> 4, hq = item & 15, hk = hq >> 3, tpos = tok & (SEQ - 1);
        float q[64]; const u16* qp = p.h + (size_t)tok * EVEN_IN + E_Q + hq * 64;
#pragma unroll
        for (int i = 0; i < 8; ++i) { const u4 w = *(const u4*)(qp + i * 8);
#pragma unroll
            for (int e = 0; e < 4; ++e) { q[i * 8 + 2 * e] = lo16(w[e]); q[i * 8 + 2 * e + 1] = hi16(w[e]); } }
        { const float* rp = p.rope + tok * 16;
#pragma unroll
          for (int f = 0; f < 8; ++f) { const float c = rp[f], s = rp[8 + f], t1 = q[f], t2 = q[8 + f]; q[f] = t1 * c - t2 * s; q[8 + f] = t2 * c + t1 * s; } }
        float sc[2];
#pragma unroll
        for (int half = 0; half < 2; ++half) { const int w = lane + half * 64; const int kp = tpos - w;
            float s = -INFINITY;
            if (kp >= 0) { const int kt = tok - w; const u16* kptr = p.h + (size_t)kt * EVEN_IN + E_K + hk * 64; const float* rp = p.rope + kt * 16; float kk[64];
#pragma unroll
                for (int i = 0; i < 8; ++i) { const u4 ww = *(const u4*)(kptr + i * 8);
#pragma unroll
                    for (int e = 0; e < 4; ++e) { kk[i * 8 + 2 * e] = lo16(ww[e]); kk[i * 8 + 2 * e + 1] = hi16(ww[e]); } }
#pragma unroll
                for (int f = 0; f < 8; ++f) { const float c = rp[f], sn = rp[8 + f], t1 = kk[f], t2 = kk[8 + f]; kk[f] = t1 * c - t2 * sn; kk[8 + f] = t2 * c + t1 * sn; }
                s = 0.f;
#pragma unroll
                for (int d = 0; d < 64; ++d) s += q[d] * kk[d];
                s *= 0.125f; }
            sc[half] = s; }
        const float sink = p.even_b_sinks[j * 16 + hq];
        const float m = fmaxf(wave_max(fmaxf(sc[0], sc[1])), sink);
        const float p0 = __expf(sc[0] - m), p1 = __expf(sc[1] - m);
        const float den = wave_sum(p0 + p1) + __expf(sink - m);
        float o = 0.f;
        for (int w = 0; w < 128; ++w) { const float pw = __shfl(w < 64 ? p0 : p1, w & 63); const int kp = tpos - w;
            if (kp >= 0) o += pw * bf2f(p.h[(size_t)(tok - w) * EVEN_IN + E_VV + hk * 64 + lane]); }
        const float bg = bf2f(p.h[(size_t)tok * EVEN_IN + E_BG + hq * 64 + lane]);
        p.mix[(size_t)tok * DM + 1024 + hq * 64 + lane] = f2bf(o / den * silu_f(bg)); }
}
__device__ __forceinline__ void st_lru_conv(const Params& p, int j, int gt, int gn) {
    const float* cw = p.odd_conv_w + j * 4 * 1024; const float* cb = p.odd_conv_b + j * 1024;
    for (int i = gt; i < NTOK * 1024; i += gn) { const int tok = i >> 10, c = i & 1023, tpos = tok & (SEQ - 1);
        float a = cb[c];
#pragma unroll
        for (int k = 0; k < 4; ++k) { const int d = 3 - k; if (tpos - d >= 0) a += cw[k * 1024 + c] * bf2f(p.h[(size_t)(tok - d) * ODD_IN + O_XC + c]); }
        p.T0[i] = a; }
}
__device__ __forceinline__ void st_lru_gates(const Params& p, int j, int gt, int gn) {
    const float* wa = p.odd_w_a + (size_t)j * 8 * 128 * 128; const float* wx = p.odd_w_x + (size_t)j * 8 * 128 * 128;
    for (int i = gt; i < NTOK * 1024; i += gn) { const int tok = i >> 10, c = i & 1023, hd = c >> 7, jj = c & 127;
        float ra = p.odd_b_a[j * 1024 + c], rx = p.odd_b_x[j * 1024 + c]; const float* xr = p.T0 + (size_t)tok * 1024 + hd * 128;
        for (int k = 0; k < 128; ++k) { const float xv = xr[k]; ra += xv * wa[((size_t)hd * 128 + k) * 128 + jj]; rx += xv * wx[((size_t)hd * 128 + k) * 128 + jj]; }
        const float r = sigmoid_f(ra), ig = sigmoid_f(rx); const float lam = p.odd_lam[j * 1024 + c];
        const float sp = log1pf(expf(-lam)); const float la = -8.0f * r * sp;
        p.T1[i] = expf(la); p.T2[i] = sqrtf(-expm1f(2.0f * la)) * (ig * p.T0[i]); }
}
__device__ __forceinline__ void st_lru_scan(const Params& p, int gt, int gn) {
    for (int i = gt; i < NBATCH * 1024; i += gn) { const int b = i >> 10, c = i & 1023; float hst = 0.f;
        for (int t = 0; t < SEQ; ++t) { const size_t tok = (size_t)b * SEQ + t; hst = p.T1[tok * 1024 + c] * hst + p.T2[tok * 1024 + c];
            p.mix[tok * DM + c] = f2bf(hst * silu_f(bf2f(p.h[tok * ODD_IN + O_CG + c]))); } }
}
__device__ __forceinline__ void st_pool_pre(const Params& p, int gt, int gn) {
    for (int i = gt; i < NTOK * 1024; i += gn) { const int tok = i >> 10, c = i & 1023, g = c >> 8, w = 2 << g, tpos = tok & (SEQ - 1);
        const int n = min(tpos + 1, w); float s = 0.f;
        for (int k = 0; k < n; ++k) s += bf2f(p.h[(size_t)(tok - k) * ODD_IN + O_XD + c]);
        p.T0[i] = s / (float)n - bf2f(p.h[(size_t)tok * ODD_IN + O_XD + c]); }
}
__device__ __forceinline__ void st_pool_mm(const Params& p, int j, int gt, int gn) {
    const float* wp = p.odd_w_pool + (size_t)j * 4 * 256 * 256;
    for (int i = gt; i < NTOK * 1024; i += gn) { const int tok = i >> 10, c = i & 1023, g = c >> 8, jj = c & 255;
        float a = 0.f; const float* pr = p.T0 + (size_t)tok * 1024 + g * 256;
        for (int k = 0; k < 256; ++k) a += pr[k] * wp[((size_t)g * 256 + k) * 256 + jj];
        a *= p.odd_d_scale[j * 1024 + c] * silu_f(bf2f(p.h[(size_t)tok * ODD_IN + O_DG + c]));
        p.mix[(size_t)tok * DM + 1024 + c] = f2bf(a); }
}

struct EpiH {
    static constexpr bool PERM = true, AFTER_DRAIN = false;
    u16* O; int ldc;
    __device__ __forceinline__ void operator()(const pg8::f32x4 (&acc)[2][2][4][2], const pg8::Unit& u, int wr, int wc, int fr, int fq) const {
        const int row0 = u.pm * 256 + wr * 64 + fr, col0 = u.pn * 256 + wc * 32 + 8 * fq;
#pragma unroll
        for (int ai = 0; ai < 2; ++ai)
#pragma unroll
            for (int m = 0; m < 4; ++m) { u16* rowp = O + (size_t)(row0 + ai * 128 + m * 16) * ldc + col0;
#pragma unroll
                for (int bj = 0; bj < 2; ++bj) { const pg8::f32x4 v0 = acc[ai][bj][m][0], v1 = acc[ai][bj][m][1];
                    u4 w; w[0] = pg8::cvt_pk_bf16(v0[0], v0[1]); w[1] = pg8::cvt_pk_bf16(v0[2], v0[3]); w[2] = pg8::cvt_pk_bf16(v1[0], v1[1]); w[3] = pg8::cvt_pk_bf16(v1[2], v1[3]);
                    *(u4*)(rowp + bj * 128) = w; } }
    }
};
struct EpiZ {
    static constexpr bool PERM = false, AFTER_DRAIN = false;
    const float* X; float* Z;
    __device__ __forceinline__ void operator()(const pg8::f32x4 (&acc)[2][2][4][2], const pg8::Unit& u, int wr, int wc, int fr, int fq) const {
        const int row0 = u.pm * 256 + wr * 64 + fr, col0 = u.pn * 256 + wc * 32 + 4 * fq;
#pragma unroll
        for (int ai = 0; ai < 2; ++ai)
#pragma unroll
            for (int m = 0; m < 4; ++m) { const size_t ro = (size_t)(row0 + ai * 128 + m * 16) * DM + col0;
#pragma unroll
                for (int bj = 0; bj < 2; ++bj)
#pragma unroll
                    for (int n = 0; n < 2; ++n) { const size_t o = ro + bj * 128 + n * 16; const pg8::f32x4 xv = *(const pg8::f32x4*)(X + o);
                        *(pg8::f32x4*)(Z + o) = xv * DN_ALPHA + acc[ai][bj][m][n]; } }
    }
};

typedef short bf8 __attribute__((ext_vector_type(8)));
#define MFMA16(P, Q, C) __builtin_amdgcn_mfma_f32_16x16x32_bf16((P), (Q), (C), 0, 0, 0)

constexpr int GM_LD = 136;
__device__ __forceinline__ void gmlp_unit(const Params& p, int j, int unit, unsigned char* lds, int tid) {
    u16* Wl = (u16*)lds; u16* Vt = Wl + 128 * GM_LD; float* stat = (float*)(Vt + 128 * GM_LD);
    const int lane = tid & 63, wid = tid >> 6, fr = lane & 15, fq = lane >> 4;
    const int g = unit & 7, tok0 = (unit >> 3) * 128;
    const float* lng = p.even_a_ln_g + j * 1024 + g * 128; const float* lnb = p.even_a_ln_b + j * 1024 + g * 128;
    const float* ws = p.even_a_ws + ((size_t)j * 8 + g) * 128 * 128; const float* bs = p.even_a_bs + (j * 8 + g) * 128;
    for (int r = 0; r < 16; ++r) { const int tl = wid * 16 + r; const u16* vp = p.h + (size_t)(tok0 + tl) * EVEN_IN + E_V + lane * 16;
        float v[16]; const u4 a = *(const u4*)vp, b = *(const u4*)(vp + 8);
#pragma unroll
        for (int i = 0; i < 4; ++i) { v[2 * i] = lo16(a[i]); v[2 * i + 1] = hi16(a[i]); v[8 + 2 * i] = lo16(b[i]); v[8 + 2 * i + 1] = hi16(b[i]); }
        float s = 0.f;
#pragma unroll
        for (int i = 0; i < 16; ++i) s += v[i];
        s = wave_sum(s); const float mu = s * (1.0f / 1024.0f); float q = 0.f;
#pragma unroll
        for (int i = 0; i < 16; ++i) { const float d = v[i] - mu; q += d * d; }
        q = wave_sum(q);
        if (lane == 0) { stat[tl * 2] = mu; stat[tl * 2 + 1] = rsqrtf(q * (1.0f / 1024.0f) + LN_EPS); } }
    for (int i = tid; i < 128 * 32; i += 512) { const int s4 = (i & 31) * 4, t = i >> 5; const f4 w = *(const f4*)(ws + t * 128 + s4);
        u2 o; o[0] = pack2(s4 <= t ? w[0] : 0.f, s4 + 1 <= t ? w[1] : 0.f); o[1] = pack2(s4 + 2 <= t ? w[2] : 0.f, s4 + 3 <= t ? w[3] : 0.f);
        *(u2*)(Wl + t * GM_LD + s4) = o; }
    __syncthreads();
    for (int i = tid; i < 128 * 16; i += 512) { const int d8 = (i & 15) * 8, s = i >> 4; const u4 w = *(const u4*)(p.h + (size_t)(tok0 + s) * EVEN_IN + E_V + g * 128 + d8);
        const float mu = stat[s * 2], rs = stat[s * 2 + 1];
#pragma unroll
        for (int e = 0; e < 4; ++e) { const float v0 = (lo16(w[e]) - mu) * rs * lng[d8 + 2 * e] + lnb[d8 + 2 * e], v1 = (hi16(w[e]) - mu) * rs * lng[d8 + 2 * e + 1] + lnb[d8 + 2 * e + 1];
            Vt[(d8 + 2 * e) * GM_LD + s] = f2bf(v0); Vt[(d8 + 2 * e + 1) * GM_LD + s] = f2bf(v1); } }
    __syncthreads();
    const int dt = wid; bf8 P[4];
#pragma unroll
    for (int ks = 0; ks < 4; ++ks) P[ks] = *(const bf8*)(Vt + (dt * 16 + fr) * GM_LD + ks * 32 + fq * 8);
#pragma unroll
    for (int tt = 0; tt < 8; ++tt) { f4 acc = {0.f, 0.f, 0.f, 0.f};
#pragma unroll
        for (int ks = 0; ks <= tt / 2; ++ks) { const bf8 Q = *(const bf8*)(Wl + (tt * 16 + fr) * GM_LD + ks * 32 + fq * 8); acc = MFMA16(P[ks], Q, acc); }
        const int tl = tt * 16 + fr, c = g * 128 + dt * 16 + fq * 4; const size_t hro = (size_t)(tok0 + tl) * EVEN_IN;
        const float bb = bs[tl]; const u2 uu = *(const u2*)(p.h + hro + E_U + c), gg = *(const u2*)(p.h + hro + E_AG + c);
        u2 o; o[0] = pack2(lo16(uu[0]) * (acc[0] + bb) * silu_f(lo16(gg[0])), hi16(uu[0]) * (acc[1] + bb) * silu_f(hi16(gg[0])));
        o[1] = pack2(lo16(uu[1]) * (acc[2] + bb) * silu_f(lo16(gg[1])), hi16(uu[1]) * (acc[3] + bb) * silu_f(hi16(gg[1])));
        *(u2*)(p.mix + (size_t)(tok0 + tl) * DM + c) = o; }
    __syncthreads();
}
__device__ __forceinline__ void st_gmlp_fast(const Params& p, int j, unsigned char* lds, int bid, int nblk, int tid) {
#pragma unroll 1
    for (int u = bid; u < 512; u += nblk) gmlp_unit(p, j, u, lds, tid);
}

constexpr int AT_KLD = 72, AT_VLD = 264, AT_HPU = 4;
__device__ __forceinline__ void attn_unit(const Params& p, int j, int unit, unsigned char* lds, int tid) {
    u16* Kl = (u16*)lds; u16* Vt = Kl + 256 * AT_KLD;
    const int lane = tid & 63, wid = tid >> 6, fr = lane & 15, fq = lane >> 4;
    const int hgrp = unit & 1, hk = (unit >> 1) & 1, nb = (unit >> 2) & 15, b = unit >> 6;
    const int tokq0 = b * SEQ + nb * 128;
    const int tokk0 = tokq0 - 128;
    for (int i = tid; i < 256 * 4; i += 512) { const int c4 = i & 3, key = i >> 2; u4 w0 = {0u, 0u, 0u, 0u}, w1 = {0u, 0u, 0u, 0u};
        if (nb > 0 || key >= 128) { const int tok = tokk0 + key; const u16* kp = p.h + (size_t)tok * EVEN_IN + E_K + hk * 64 + c4 * 16; w0 = *(const u4*)kp; w1 = *(const u4*)(kp + 8);
            if (c4 == 0) { const float* rp = p.rope + tok * 16; const f4 c0 = *(const f4*)rp, c1 = *(const f4*)(rp + 4), s0 = *(const f4*)(rp + 8), s1 = *(const f4*)(rp + 12);
                u4 n0, n1;
#pragma unroll
                for (int e = 0; e < 4; ++e) { const float ca = e < 2 ? c0[2 * e] : c1[2 * e - 4], cb = e < 2 ? c0[2 * e + 1] : c1[2 * e - 3], sa = e < 2 ? s0[2 * e] : s1[2 * e - 4], sb = e < 2 ? s0[2 * e + 1] : s1[2 * e - 3];
                    const float a1 = lo16(w0[e]), b1 = hi16(w0[e]), a2 = lo16(w1[e]), b2 = hi16(w1[e]);
                    n0[e] = pack2(a1 * ca - a2 * sa, b1 * cb - b2 * sb); n1[e] = pack2(a2 * ca + a1 * sa, b2 * cb + b1 * sb); }
                w0 = n0; w1 = n1; } }
        *(u4*)(Kl + key * AT_KLD + c4 * 16) = w0; *(u4*)(Kl + key * AT_KLD + c4 * 16 + 8) = w1; }
    for (int i = tid; i < 256 * 8; i += 512) { const int d8 = (i & 7) * 8, key = i >> 3; u4 w = {0u, 0u, 0u, 0u};
        if (nb > 0 || key >= 128) w = *(const u4*)(p.h + (size_t)(tokk0 + key) * EVEN_IN + E_VV + hk * 64 + d8);
#pragma unroll
        for (int e = 0; e < 4; ++e) { Vt[(d8 + 2 * e) * AT_VLD + key] = (u16)(w[e] & 0xffffu); Vt[(d8 + 2 * e + 1) * AT_VLD + key] = (u16)(w[e] >> 16); } }
    __syncthreads();
    const int qi = wid * 16 + fr, tokq = tokq0 + qi;
#pragma unroll 1
    for (int hh = 0; hh < AT_HPU; ++hh) { const int hq = hk * 8 + hgrp * AT_HPU + hh;
        bf8 Qf[2];
        { const u16* qp = p.h + (size_t)tokq * EVEN_IN + E_Q + hq * 64 + fq * 8; u4 w0 = *(const u4*)qp; const u4 w1 = *(const u4*)(qp + 32);
          float v[8];
#pragma unroll
          for (int e = 0; e < 4; ++e) { v[2 * e] = lo16(w0[e]); v[2 * e + 1] = hi16(w0[e]); }
          const float* rp = p.rope + tokq * 16; const f4 c0 = *(const f4*)rp, c1 = *(const f4*)(rp + 4), s0 = *(const f4*)(rp + 8), s1 = *(const f4*)(rp + 12);
          float cs[8], sn[8];
#pragma unroll
          for (int e = 0; e < 4; ++e) { cs[e] = c0[e]; cs[4 + e] = c1[e]; sn[e] = s0[e]; sn[4 + e] = s1[e]; }
#pragma unroll
          for (int e = 0; e < 8; ++e) { const float other = __shfl_xor(v[e], 16);
              const float rot = (fq == 0) ? (v[e] * cs[e] - other * sn[e]) : (v[e] * cs[e] + other * sn[e]); v[e] = (fq < 2) ? rot : v[e]; }
#pragma unroll
          for (int e = 0; e < 4; ++e) w0[e] = pack2(v[2 * e] * 0.125f, v[2 * e + 1] * 0.125f);
          u4 w1s;
#pragma unroll
          for (int e = 0; e < 4; ++e) w1s[e] = pack2(lo16(w1[e]) * 0.125f, hi16(w1[e]) * 0.125f);
          Qf[0] = __builtin_bit_cast(bf8, w0); Qf[1] = __builtin_bit_cast(bf8, w1s); }
        f4 S[9];
#pragma unroll
        for (int kt = 0; kt < 9; ++kt) { S[kt] = (f4){0.f, 0.f, 0.f, 0.f};
#pragma unroll
            for (int ks = 0; ks < 2; ++ks) { const bf8 Kf = *(const bf8*)(Kl + ((wid + kt) * 16 + fr) * AT_KLD + ks * 32 + fq * 8); S[kt] = MFMA16(Kf, Qf[ks], S[kt]); } }
        const float sink = p.even_b_sinks[j * 16 + hq];
        float m = sink;
        int qlo = (nb > 0) ? qi + 1 : max(qi + 1, 128); asm volatile("" : "+v"(qlo));
#pragma unroll
        for (int kt = 0; kt < 9; ++kt)
#pragma unroll
            for (int r = 0; r < 4; ++r) { const int kj = (wid + kt) * 16 + fq * 4 + r; const bool ok = (unsigned)(kj - qlo) <= (unsigned)(qi + 128 - qlo);
                S[kt][r] = ok ? S[kt][r] : -INFINITY; m = fmaxf(m, S[kt][r]); }
        m = fmaxf(m, __shfl_xor(m, 16)); m = fmaxf(m, __shfl_xor(m, 32));
        float l = 0.f;
#pragma unroll
        for (int kt = 0; kt < 9; ++kt)
#pragma unroll
            for (int r = 0; r < 4; ++r) { const float e = __expf(S[kt][r] - m); S[kt][r] = e; l += e; }
        l += __shfl_xor(l, 16); l += __shfl_xor(l, 32); l += __expf(sink - m);
        f4 O[4];
#pragma unroll
        for (int dt = 0; dt < 4; ++dt) O[dt] = (f4){0.f, 0.f, 0.f, 0.f};
#pragma unroll
        for (int pr = 0; pr < 5; ++pr) { const int ktA = 2 * pr, ktB = 2 * pr + 1;
            u4 pw; pw[0] = pack2(S[ktA][0], S[ktA][1]); pw[1] = pack2(S[ktA][2], S[ktA][3]);
            if (ktB < 9) { pw[2] = pack2(S[ktB < 9 ? ktB : 8][0], S[ktB < 9 ? ktB : 8][1]); pw[3] = pack2(S[ktB < 9 ? ktB : 8][2], S[ktB < 9 ? ktB : 8][3]); } else { pw[2] = 0u; pw[3] = 0u; }
            const bf8 Pf = __builtin_bit_cast(bf8, pw);
            const int tA = wid + ktA, tB = min(wid + ktB, 15);
#pragma unroll
            for (int dt = 0; dt < 4; ++dt) { const u16* vr = Vt + (dt * 16 + fr) * AT_VLD + fq * 4; const u2 va = *(const u2*)(vr + tA * 16), vb = *(const u2*)(vr + tB * 16);
                u4 vw; vw[0] = va[0]; vw[1] = va[1]; vw[2] = vb[0]; vw[3] = vb[1];
                O[dt] = MFMA16(__builtin_bit_cast(bf8, vw), Pf, O[dt]); } }
        const float inv = 1.0f / l;
#pragma unroll
        for (int dt = 0; dt < 4; ++dt) { const int c = hq * 64 + dt * 16 + fq * 4; const u2 gg = *(const u2*)(p.h + (size_t)tokq * EVEN_IN + E_BG + c);
            u2 o; o[0] = pack2(O[dt][0] * inv * silu_f(lo16(gg[0])), O[dt][1] * inv * silu_f(hi16(gg[0])));
            o[1] = pack2(O[dt][2] * inv * silu_f(lo16(gg[1])), O[dt][3] * inv * silu_f(hi16(gg[1])));
            *(u2*)(p.mix + (size_t)tokq * DM + 1024 + c) = o; }
    }
    __syncthreads();
}
__device__ __forceinline__ void st_attn_fast(const Params& p, int j, unsigned char* lds, int bid, int nblk, int tid) {
#pragma unroll 1
    for (int u = bid; u < 256; u += nblk) attn_unit(p, j, u, lds, tid);
}

__device__ __forceinline__ void lru_unit(const Params& p, int j, int unit, unsigned char* lds, int tid) {
    float* cwl = (float*)lds;
    float* agg = cwl + 640;
    const int lane = tid & 63, wid = tid >> 6, fr = lane & 15, fq = lane >> 4;
    const int b = unit >> 6, hd = (unit >> 3) & 7, cgp = unit & 7;
    const int ch0 = hd * 128 + cgp * 16;
    for (int i = tid; i < 640; i += 512) cwl[i] = (i < 512) ? p.odd_conv_w[j * 4096 + (i >> 7) * 1024 + hd * 128 + (i & 127)] : p.odd_conv_b[j * 1024 + hd * 128 + (i - 512)];
    bf8 WA[4], WX[4];
    { const float* wa = p.odd_w_a + ((size_t)j * 8 + hd) * 128 * 128 + cgp * 16 + fr; const float* wx = p.odd_w_x + ((size_t)j * 8 + hd) * 128 * 128 + cgp * 16 + fr;
#pragma unroll
      for (int ks = 0; ks < 4; ++ks) { u4 a, x;
#pragma unroll
          for (int e = 0; e < 4; ++e) { const int k = ks * 32 + fq * 8 + 2 * e; a[e] = pack2(wa[k * 128], wa[(k + 1) * 128]); x[e] = pack2(wx[k * 128], wx[(k + 1) * 128]); }
          WA[ks] = __builtin_bit_cast(bf8, a); WX[ks] = __builtin_bit_cast(bf8, x); } }
    float ba[4], bx[4], sp[4], cw4[4][4], cb4[4];
#pragma unroll
    for (int r = 0; r < 4; ++r) { const int c = ch0 + fq * 4 + r; ba[r] = p.odd_b_a[j * 1024 + c]; bx[r] = p.odd_b_x[j * 1024 + c]; sp[r] = -8.0f * log1pf(expf(-p.odd_lam[j * 1024 + c]));
        cb4[r] = p.odd_conv_b[j * 1024 + c];
#pragma unroll
        for (int k = 0; k < 4; ++k) cw4[k][r] = p.odd_conv_w[j * 4096 + k * 1024 + c]; }
    __syncthreads();
    const int seg0 = b * SEQ + wid * 256;
    float carry[4] = {0.f, 0.f, 0.f, 0.f}, aprod[4] = {1.f, 1.f, 1.f, 1.f};
#pragma unroll 1
    for (int pass = 0; pass < 2; ++pass) {
#pragma unroll 1
        for (int tl = 0; tl < 16; ++tl) {
            const int tokB = seg0 + tl * 16 + fr, tposB = tokB & (SEQ - 1);
            int loff = 0; asm volatile("" : "+v"(loff)); const float* cw = cwl + loff;
            const u16* xrow = p.h + (size_t)tokB * ODD_IN + O_XC + hd * 128;
            f4 accA = {0.f, 0.f, 0.f, 0.f}, accX = {0.f, 0.f, 0.f, 0.f};
#pragma unroll
            for (int ks = 0; ks < 4; ++ks) { const int kc = ks * 32 + fq * 8; float xv[8];
                { const f4 b0 = *(const f4*)(cw + 512 + kc), b1 = *(const f4*)(cw + 512 + kc + 4);
#pragma unroll
                  for (int e = 0; e < 4; ++e) { xv[e] = b0[e]; xv[4 + e] = b1[e]; } }
#pragma unroll
                for (int k = 0; k < 4; ++k) { u4 v = {0u, 0u, 0u, 0u}; if (tposB - 3 + k >= 0) v = *(const u4*)(xrow - (ptrdiff_t)(3 - k) * ODD_IN + kc);
                    const f4 w0 = *(const f4*)(cw + k * 128 + kc), w1 = *(const f4*)(cw + k * 128 + kc + 4);
#pragma unroll
                    for (int e = 0; e < 2; ++e) { xv[2 * e] += w0[2 * e] * lo16(v[e]); xv[2 * e + 1] += w0[2 * e + 1] * hi16(v[e]); xv[4 + 2 * e] += w1[2 * e] * lo16(v[2 + e]); xv[4 + 2 * e + 1] += w1[2 * e + 1] * hi16(v[2 + e]); } }
                u4 xw;
#pragma unroll
                for (int e = 0; e < 4; ++e) xw[e] = pack2(xv[2 * e], xv[2 * e + 1]);
                const bf8 Xf = __builtin_bit_cast(bf8, xw);
                accA = MFMA16(WA[ks], Xf, accA); accX = MFMA16(WX[ks], Xf, accX); }
            float xc4[4];
#pragma unroll
            for (int r = 0; r < 4; ++r) xc4[r] = cb4[r];
#pragma unroll
            for (int k = 0; k < 4; ++k) { u2 v = {0u, 0u}; if (tposB - 3 + k >= 0) v = *(const u2*)(xrow - (ptrdiff_t)(3 - k) * ODD_IN + cgp * 16 + fq * 4);
                xc4[0] += cw4[k][0] * lo16(v[0]); xc4[1] += cw4[k][1] * hi16(v[0]); xc4[2] += cw4[k][2] * lo16(v[1]); xc4[3] += cw4[k][3] * hi16(v[1]); }
            float hv[4];
#pragma unroll
            for (int r = 0; r < 4; ++r) { const float rg = sigmoid_f(accA[r] + ba[r]), ig = sigmoid_f(accX[r] + bx[r]); const float la = rg * sp[r];
                float a = expf(la); float bt = sqrtf(-expm1f(2.0f * la)) * (ig * xc4[r]);
#pragma unroll
                for (int d = 1; d < 16; d <<= 1) { const float ap = __shfl_up(a, d, 16), bp = __shfl_up(bt, d, 16); if (fr >= d) { bt = a * bp + bt; a = a * ap; } }
                const float h = a * carry[r] + bt; hv[r] = h;
                carry[r] = __shfl(h, 15, 16); aprod[r] *= __shfl(a, 15, 16); }
            if (pass == 1) { const u2 gg = *(const u2*)(p.h + (size_t)tokB * ODD_IN + O_CG + ch0 + fq * 4);
                u2 o; o[0] = pack2(hv[0] * silu_f(lo16(gg[0])), hv[1] * silu_f(hi16(gg[0]))); o[1] = pack2(hv[2] * silu_f(lo16(gg[1])), hv[3] * silu_f(hi16(gg[1])));
                *(u2*)(p.mix + (size_t)tokB * DM + ch0 + fq * 4) = o; }
        }
        if (pass == 0) {
            if (fr == 0) {
#pragma unroll
                for (int r = 0; r < 4; ++r) { agg[(wid * 16 + fq * 4 + r) * 2] = aprod[r]; agg[(wid * 16 + fq * 4 + r) * 2 + 1] = carry[r]; } }
            __syncthreads();
#pragma unroll
            for (int r = 0; r < 4; ++r) { float hin = 0.f;
                for (int s = 0; s < wid; ++s) hin = agg[(s * 16 + fq * 4 + r) * 2] * hin + agg[(s * 16 + fq * 4 + r) * 2 + 1];
                carry[r] = hin; }
        }
    }
    __syncthreads();
}
__device__ __forceinline__ void st_lru_fast(const Params& p, int j, unsigned char* lds, int bid, int nblk, int tid) {
#pragma unroll 1
    for (int u = bid; u < 256; u += nblk) lru_unit(p, j, u, lds, tid);
}

constexpr int PL_LD = 264;
__device__ __forceinline__ void pool_unit(const Params& p, int j, int unit, unsigned char* lds, int tid) {
    u16* Al = (u16*)lds;
    const int lane = tid & 63, wid = tid >> 6, fr = lane & 15, fq = lane >> 4;
    const int g = unit & 3, tok0 = (unit >> 2) * 128, w = 2 << g;
    {
        const int c8 = (tid & 31) * 8, seg = tid >> 5; const int t0 = tok0 + seg * 8, tpos0 = t0 & (SEQ - 1);
        const u16* base = p.h + O_XD + g * 256 + c8;
        float S[8];
#pragma unroll
        for (int e = 0; e < 8; ++e) S[e] = 0.f;
        for (int k = 1; k < w; ++k) if (tpos0 - k >= 0) { const u4 v = *(const u4*)(base + (size_t)(t0 - k) * ODD_IN);
#pragma unroll
            for (int e = 0; e < 4; ++e) { S[2 * e] += lo16(v[e]); S[2 * e + 1] += hi16(v[e]); } }
#pragma unroll 2
        for (int r = 0; r < 8; ++r) { const int tok = t0 + r, tpos = tpos0 + r; const u4 v = *(const u4*)(base + (size_t)tok * ODD_IN);
            const float rn = 1.0f / (float)min(tpos + 1, w); u4 o;
#pragma unroll
            for (int e = 0; e < 4; ++e) { const float x0 = lo16(v[e]), x1 = hi16(v[e]); S[2 * e] += x0; S[2 * e + 1] += x1; o[e] = pack2(S[2 * e] * rn - x0, S[2 * e + 1] * rn - x1); }
            *(u4*)(Al + (seg * 8 + r) * PL_LD + c8) = o;
            if (tpos - w + 1 >= 0) { const u4 q = *(const u4*)(base + (size_t)(tok - w + 1) * ODD_IN);
#pragma unroll
                for (int e = 0; e < 4; ++e) { S[2 * e] -= lo16(q[e]); S[2 * e + 1] -= hi16(q[e]); } } }
    }
    __syncthreads();
    const int wr = wid >> 2, wc = wid & 3;
    const u16* wp = p.wpT + ((size_t)g * 256 + wc * 64 + fr) * 256 + fq * 8;
    const u16* ap = Al + (wr * 64 + fr) * PL_LD + fq * 8;
    f4 acc[4][4];
#pragma unroll
    for (int nt = 0; nt < 4; ++nt)
#pragma unroll
        for (int mt = 0; mt < 4; ++mt) acc[nt][mt] = (f4){0.f, 0.f, 0.f, 0.f};
    bf8 Pc[4], Pn[4];
#pragma unroll
    for (int nt = 0; nt < 4; ++nt) Pc[nt] = *(const bf8*)(wp + nt * 16 * 256);
#pragma unroll
    for (int ks = 0; ks < 8; ++ks) {
        if (ks < 7) {
#pragma unroll
            for (int nt = 0; nt < 4; ++nt) Pn[nt] = *(const bf8*)(wp + nt * 16 * 256 + (ks + 1) * 32); }
        bf8 Q[4];
#pragma unroll
        for (int mt = 0; mt < 4; ++mt) Q[mt] = *(const bf8*)(ap + mt * 16 * PL_LD + ks * 32);
#pragma unroll
        for (int nt = 0; nt < 4; ++nt)
#pragma unroll
            for (int mt = 0; mt < 4; ++mt) acc[nt][mt] = MFMA16(Pc[nt], Q[mt], acc[nt][mt]);
#pragma unroll
        for (int nt = 0; nt < 4; ++nt) Pc[nt] = Pn[nt];
    }
#pragma unroll
    for (int nt = 0; nt < 4; ++nt) { const int c = g * 256 + wc * 64 + nt * 16 + fq * 4; const f4 ds = *(const f4*)(p.odd_d_scale + j * 1024 + c);
#pragma unroll
        for (int mt = 0; mt < 4; ++mt) { const int tok = tok0 + wr * 64 + mt * 16 + fr; const u2 gg = *(const u2*)(p.h + (size_t)tok * ODD_IN + O_DG + c);
            u2 o; o[0] = pack2(acc[nt][mt][0] * ds[0] * silu_f(lo16(gg[0])), acc[nt][mt][1] * ds[1] * silu_f(hi16(gg[0])));
            o[1] = pack2(acc[nt][mt][2] * ds[2] * silu_f(lo16(gg[1])), acc[nt][mt][3] * ds[3] * silu_f(hi16(gg[1])));
            *(u2*)(p.mix + (size_t)tok * DM + 1024 + c) = o; } }
    __syncthreads();
}
__device__ __forceinline__ void st_pool_fast(const Params& p, int j, unsigned char* lds, int bid, int nblk, int tid) {
#pragma unroll 1
    for (int u = bid; u < 256; u += nblk) pool_unit(p, j, u, lds, tid);
}
#ifndef MK_ONE_LAUNCH
#define MK_ONE_LAUNCH 1
#endif

constexpr int NSLOT = 1 + 4 * 8;
constexpr int LDS_BYTES = 131072;
__host__ __device__ inline bool slot_used(int s) { if (s == 0) return true; const int layer = (s - 1) >> 3, k = (s - 1) & 7; return k < 5; }

__device__ __forceinline__ void cvt_next_weights(const Params& p, int layer, float* sm, int bid_) {
    const int j = layer >> 1;
    const float* wo = (layer & 1) ? p.odd_w_out + (size_t)j * DM * DM : p.even_w_out + (size_t)j * DM * DM;
    cvt_wT_all(wo, p.wt_out, DM, DM, sm, bid_, gridDim.x);
    if (layer < 3) { const int nl = layer + 1, nj = nl >> 1;
        if (nl & 1) cvt_wT_all(p.odd_w_in + (size_t)nj * DM * ODD_IN, p.wt_in, DM, ODD_IN, sm, bid_, gridDim.x);
        else cvt_wT_all(p.even_w_in + (size_t)nj * DM * EVEN_IN, p.wt_in, DM, EVEN_IN, sm, bid_, gridDim.x); }
}

__device__ __forceinline__ void run_slot(const Params& p, int s, PG8_LAS unsigned char* lds, float* smf) {
    int tid_ = threadIdx.x; asm volatile("" : "+v"(tid_)); int bid_ = blockIdx.x; asm volatile("" : "+s"(bid_));
    const int gt = bid_ * 512 + tid_, gn = gridDim.x * 512;
    if (s == 0) { st_rope(p, gt, gn); st_cvt_x(p.x, p.xb, gt, gn); cvt_wT_all(p.even_w_in, p.wt_in, DM, EVEN_IN, smf, bid_, gridDim.x); return; }
    const int layer = (s - 1) >> 3, k = (s - 1) & 7, j = layer >> 1; const bool odd = layer & 1;
    const int gemm_z_slot = 3, ln_slot = 4;
    if (k == 0) { const int N = odd ? ODD_IN : EVEN_IN; pg8::Gemm g{p.xb, p.wt_in, NTOK, N, DM}; pg8::StaticOrder S; S.init(NTOK, N, gridDim.x, bid_);
        EpiH E{p.h, N}; pg8::gemm_phase<EpiH, pg8::StaticOrder, false>(lds, g, S, E, nullptr); return; }
    if (k == gemm_z_slot) { pg8::Gemm g{p.mix, p.wt_out, NTOK, DM, DM}; pg8::StaticOrder S; S.init(NTOK, DM, gridDim.x, bid_);
        EpiZ E{layer == 0 ? p.x : p.out, p.out}; pg8::gemm_phase<EpiZ, pg8::StaticOrder, false>(lds, g, S, E, nullptr); return; }
    if (k == ln_slot) { const float* g = odd ? p.odd_ln_g + j * DM : p.even_ln_g + j * DM; const float* b = odd ? p.odd_ln_b + j * DM : p.even_ln_b + j * DM;
        st_ln_rows(p.out, g, b, p.out, p.xb, gt, gn); return; }
    if (!odd) {
        if (k == 1) { cvt_next_weights(p, layer, smf, bid_); }
        else if (k == 2) { st_gmlp_fast(p, j, (unsigned char*)smf, bid_, gridDim.x, tid_); st_attn_fast(p, j, (unsigned char*)smf, bid_, gridDim.x, tid_); }
    } else {
        if (k == 1) { cvt_next_weights(p, layer, smf, bid_);
            for (int g = 0; g < 4; ++g) cvt_wT_all(p.odd_w_pool + ((size_t)j * 4 + g) * 65536, p.wpT + g * 65536, 256, 256, smf, bid_, gridDim.x); }
        else if (k == 2) { st_lru_fast(p, j, (unsigned char*)smf, bid_, gridDim.x, tid_); st_pool_fast(p, j, (unsigned char*)smf, bid_, gridDim.x, tid_); }
    }
}

struct KArgs { Params p; int lo, hi; };
__global__ void __launch_bounds__(512, 2) k_mega(KArgs a) {
    extern __shared__ __attribute__((aligned(16))) unsigned char shm[];
    cg::grid_group grid = cg::this_grid();
    for (int s = a.lo; s < a.hi; ++s) {
        if (!slot_used(s)) continue;
        run_slot(a.p, s, (PG8_LAS unsigned char*)shm, (float*)shm);
        if (s + 1 < a.hi) grid.sync();
    }
}

extern "C" void kernel_launch(void* const* d_in, const int* in_sizes, int n_in, void* d_out, int out_size, void* d_ws, size_t ws_size, hipStream_t stream) {
    static int grid = 0;
    if (grid == 0) {
        int dev = 0, cus = 0, per_cu = 0;
        hipGetDevice(&dev); hipDeviceGetAttribute(&cus, hipDeviceAttributeMultiprocessorCount, dev);
        if (hipFuncSetAttribute((const void*)k_mega, hipFuncAttributeMaxDynamicSharedMemorySize, LDS_BYTES) != hipSuccess) { fprintf(stderr, "hipFuncSetAttribute failed\n"); grid = -1; return; }
        hipOccupancyMaxActiveBlocksPerMultiprocessor(&per_cu, (const void*)k_mega, 512, LDS_BYTES);
        if (per_cu < 1) { fprintf(stderr, "occupancy query says %d\n", per_cu); per_cu = 1; }
        (void)hipGetLastError();
        grid = cus;
    }
    if (grid < 0) return;
    KArgs a; memset(&a, 0, sizeof(a));
    Params& p = a.p;
    p.x = (const float*)d_in[0]; p.positions = (const int*)d_in[1];
    p.even_w_in = (const float*)d_in[2]; p.even_a_ln_g = (const float*)d_in[3]; p.even_a_ln_b = (const float*)d_in[4]; p.even_a_ws = (const float*)d_in[5];
    p.even_a_bs = (const float*)d_in[6]; p.even_b_sinks = (const float*)d_in[7]; p.even_w_out = (const float*)d_in[8]; p.even_ln_g = (const float*)d_in[9];
    p.even_ln_b = (const float*)d_in[10]; p.odd_w_in = (const float*)d_in[11]; p.odd_conv_w = (const float*)d_in[12]; p.odd_conv_b = (const float*)d_in[13];
    p.odd_w_a = (const float*)d_in[14]; p.odd_b_a = (const float*)d_in[15]; p.odd_w_x = (const float*)d_in[16]; p.odd_b_x = (const float*)d_in[17];
    p.odd_lam = (const float*)d_in[18]; p.odd_w_pool = (const float*)d_in[19]; p.odd_d_scale = (const float*)d_in[20]; p.odd_w_out = (const float*)d_in[21];
    p.odd_ln_g = (const float*)d_in[22]; p.odd_ln_b = (const float*)d_in[23];
    p.out = (float*)d_out;
    unsigned char* w = (unsigned char*)d_ws; size_t off = 0;
    auto take = [&](size_t bytes) { unsigned char* r = w + off; off += (bytes + 255) & ~(size_t)255; return r; };
    p.wt_in = (u16*)take((size_t)EVEN_IN * DM * 2); p.wt_out = (u16*)take((size_t)DM * DM * 2); p.xb = (u16*)take((size_t)NTOK * DM * 2);
    p.h = (u16*)take((size_t)NTOK * EVEN_IN * 2); p.mix = (u16*)take((size_t)NTOK * DM * 2); p.rope = (float*)take((size_t)NTOK * 16 * 4);
    p.vstat = (float*)take((size_t)NTOK * 2 * 4); p.wpT = (u16*)take((size_t)4 * 65536 * 2);
    p.T0 = (float*)take((size_t)NTOK * 1024 * 4); p.T1 = (float*)take((size_t)NTOK * 1024 * 4); p.T2 = (float*)take((size_t)NTOK * 1024 * 4);
    if (off > ws_size) { fprintf(stderr, "workspace too small: need %zu have %zu\n", off, ws_size); return; }
#if MK_ONE_LAUNCH
    a.lo = 0; a.hi = NSLOT; void* args[] = {&a};
    hipError_t e = hipLaunchCooperativeKernel((const void*)k_mega, dim3(grid), dim3(512), args, LDS_BYTES, stream);
    if (e != hipSuccess) fprintf(stderr, "cooperative launch failed: %s (grid %d)\n", hipGetErrorString(e), grid);
#else
    for (int s = 0; s < NSLOT; ++s) { if (!slot_used(s)) continue; a.lo = s; a.hi = s + 1;
        hipLaunchKernelGGL(k_mega, dim3(grid), dim3(512), LDS_BYTES, stream, a); }
#endif
}
```

```cpp
#include <hip/hip_runtime.h>
#include <hip/hip_cooperative_groups.h>
#include <cstdio>
#include <cmath>
#include <cstring>
namespace cg = cooperative_groups;
#define REP_GH 1
#define REP_CVT 1
#define REP_GMLP 1
#define REP_ATTN 1
#define REP_LRU 1
#define REP_POOL 1
#define REP_SYNC 1
namespace pg8 {
#define PG8_LAS __attribute__((address_space(3)))
typedef unsigned short bf16_t;
typedef short bf16x8 __attribute__((ext_vector_type(8)));
typedef float f32x4 __attribute__((ext_vector_type(4)));
typedef unsigned u32x4 __attribute__((ext_vector_type(4)));
constexpr int BM = 256, BK = 64, HALF = 128, HTB = HALF * BK * 2  , STAGE_BYTES = 8 * HTB, NXCD = 8, WGM = 8;

__host__ __device__ __forceinline__ int lds_byte(int r, int c) { const int st = (r >> 4) * 2 + (c >> 5), rr = r & 15, cc = c & 31, ob = rr * 64 + cc * 2; return st * 1024 + (ob ^ (((ob >> 9) & 1) << 5)); }
__host__ __device__ __forceinline__ void stage_rc(int b, int& R, int& C) { const int st = b / 1024, sb = b % 1024, swz = sb ^ (((sb >> 9) & 1) << 5); R = (st >> 1) * 16 + swz / 64; C = (st & 1) * 32 + (swz % 64) / 2; }
__host__ __device__ __forceinline__ int perm32(int rho) { const int n = rho >> 4, i = rho & 15; return 8 * (i >> 2) + 4 * n + (i & 3); }

struct Unit { int pm, pn; };
struct Gemm { const bf16_t* A; const bf16_t* Bt; int M, N, K; };

struct StaticOrder {
    int nM, nN, nwg, G, c;
    __host__ __device__ void init(int M, int N, int G_, int c_) { nM = M / BM; nN = N / BM; nwg = nM * nN; G = G_; c = c_; }
    __host__ __device__ bool next(int i, Unit& u) const {
        const long L = (long)i * G + c; if (L >= nwg) return false;
        int wgid = (int)L; { const int q = nwg / NXCD, r = nwg % NXCD, xcd = wgid % NXCD, off = wgid / NXCD; wgid = (xcd < r ? xcd * (q + 1) : r * (q + 1) + (xcd - r) * q) + off; }
        const int nig = WGM * nN, gid = wgid / nig, fm = gid * WGM, gsz = (nM - fm) < WGM ? (nM - fm) : WGM;
        u.pm = fm + ((wgid % nig) % gsz); u.pn = (wgid % nig) / gsz; return true;
    }
    __device__ __forceinline__ void a_ready(const Unit&) const {}
    __device__ __forceinline__ void done(const Unit&) const {}
};
__device__ __forceinline__ unsigned cvt_pk_bf16(float lo, float hi) { unsigned r; asm volatile("v_cvt_pk_bf16_f32 %0, %1, %2" : "=v"(r) : "v"(lo), "v"(hi)); return r; }

template <class Epi, class Sched, bool STAMP = false>
__device__ __forceinline__ void gemm_phase(PG8_LAS unsigned char* lds, const Gemm g, const Sched& S, const Epi& E, unsigned long long* stamps) {
    int tid_ = threadIdx.x; asm volatile("" : "+v"(tid_));
    const int tid = tid_, wid = __builtin_amdgcn_readfirstlane(tid >> 6), lane = tid & 63, wr = wid >> 2, wc = wid & 3, fr = lane & 15, fq = lane >> 4;
    const int K = g.K, nt = K / BK;
    int ts_lo = 0, ts_hi = 0, nts = 0; const unsigned long long rt_entry = STAMP ? (unsigned long long)wall_clock64() : 0ull;
#define PG8_STAMP() do { if (STAMP && wid == 0 && nts < 64) { const unsigned long long _c = (unsigned long long)clock64(); \
        ts_lo = (lane == nts) ? (int)(unsigned)_c : ts_lo; ts_hi = (lane == nts) ? (int)(unsigned)(_c >> 32) : ts_hi; ++nts; } } while (0)
    PG8_STAMP();
    unsigned voffA[2], voffB[2];
#pragma unroll
    for (int i = 0; i < 2; ++i) { int R, C; stage_rc(tid * 16 + i * 8192, R, C); const int Rb = Epi::PERM ? ((R & ~31) + perm32(R & 31)) : R;
        voffA[i] = (unsigned)(R * K + C) * 2u; voffB[i] = (unsigned)(Rb * K + C) * 2u; }
    const size_t kstep = (size_t)(BK * 2);
    const size_t hstep = (size_t)HALF * K * 2;
    const size_t tstep = 2 * hstep;
    const unsigned ldsw = (unsigned)wid * 1024u;
    const int aoff = lds_byte(wr * 64 + fr, fq * 8), boff = lds_byte(wc * 32 + fr, fq * 8);
#define PG8_SA(b, h) (((b) * 2 + (h)) * HTB)
#define PG8_SB(b, h) ((4 + (b) * 2 + (h)) * HTB)
#define PG8_STAGE(bufoff, gbase, voff) do { _Pragma("unroll") for (int _i = 0; _i < 2; ++_i) \
        __builtin_amdgcn_global_load_lds((const unsigned*)((const char*)(gbase) + (voff)[_i]), (PG8_LAS unsigned*)(lds + (bufoff) + ldsw + _i * 8192), 16, 0, 0); } while (0)
#define PG8_LDA(dst, b, h) do { _Pragma("unroll") for (int m = 0; m < 4; ++m) _Pragma("unroll") for (int k = 0; k < 2; ++k) dst[m][k] = *(const PG8_LAS bf16x8*)(lds + PG8_SA(b, h) + aoff + m * 2048 + k * 1024); } while (0)
#define PG8_LDB(dst, b, h) do { _Pragma("unroll") for (int n = 0; n < 2; ++n) _Pragma("unroll") for (int k = 0; k < 2; ++k) dst[n][k] = *(const PG8_LAS bf16x8*)(lds + PG8_SB(b, h) + boff + n * 2048 + k * 1024); } while (0)
#define PG8_MMA(ai, bj, At, Bt) do { __builtin_amdgcn_s_setprio(1); _Pragma("unroll") for (int m = 0; m < 4; ++m) _Pragma("unroll") for (int n = 0; n < 2; ++n) _Pragma("unroll") for (int k = 0; k < 2; ++k) \
        acc[ai][bj][m][n] = __builtin_amdgcn_mfma_f32_16x16x32_bf16(Bt[n][k], At[m][k], acc[ai][bj][m][n], 0, 0, 0); __builtin_amdgcn_s_setprio(0); } while (0)
#define PG8_WAIT_V(n) asm volatile("s_waitcnt vmcnt(" #n ")" ::: "memory")
#define PG8_WAIT_L(n) asm volatile("s_waitcnt lgkmcnt(" #n ")" ::: "memory")
#define PG8_BAR __builtin_amdgcn_s_barrier()
#define PG8_SCHED __builtin_amdgcn_sched_barrier(0)
    Unit cur, nxt; int ui = 0;
    if (!S.next(0, cur)) return;
    f32x4 acc[2][2][4][2];
#pragma unroll
    for (int a = 0; a < 2; ++a)
#pragma unroll
        for (int b = 0; b < 2; ++b)
#pragma unroll
            for (int m = 0; m < 4; ++m)
#pragma unroll
                for (int n = 0; n < 2; ++n) acc[a][b][m][n] = (f32x4){0.f, 0.f, 0.f, 0.f};
    bf16x8 At[4][2], B0[2][2], B1[2][2];
    const char* cA = (const char*)g.A + (size_t)cur.pm * tstep; const char* cB = (const char*)g.Bt + (size_t)cur.pn * tstep;
    S.a_ready(cur);
    PG8_STAGE(PG8_SB(0, 0), cB, voffB); PG8_STAGE(PG8_SA(0, 0), cA, voffA); PG8_STAGE(PG8_SB(0, 1), cB + hstep, voffB); PG8_STAGE(PG8_SA(0, 1), cA + hstep, voffA);
    if (wr == 1) PG8_BAR;
    PG8_WAIT_V(4); PG8_BAR;
    PG8_STAGE(PG8_SB(1, 0), cB + kstep, voffB); PG8_STAGE(PG8_SA(1, 0), cA + kstep, voffA); PG8_STAGE(PG8_SB(1, 1), cB + hstep + kstep, voffB);
    PG8_WAIT_V(6); PG8_BAR;
    PG8_STAMP();
    for (;;) {
        const bool has_next = S.next(ui + 1, nxt);
        const char* nA = has_next ? (const char*)g.A + (size_t)nxt.pm * tstep : cA; const char* nB = has_next ? (const char*)g.Bt + (size_t)nxt.pn * tstep : cB;
        for (int t = 0; t < nt; t += 2) {
            const bool last = (t == nt - 2);
            const char* a1 = cA + (size_t)(t + 1) * kstep;
            const char* a2 = last ? nA : cA + (size_t)(t + 2) * kstep; const char* b2 = last ? nB : cB + (size_t)(t + 2) * kstep;
            const char* a3 = a2 + kstep; const char* b3 = b2 + kstep;
            if (last && has_next) S.a_ready(nxt);
            PG8_LDB(B0, 0, 0); PG8_SCHED; PG8_LDA(At, 0, 0); PG8_STAGE(PG8_SA(1, 1), a1 + hstep, voffA);
            PG8_WAIT_L(8); PG8_BAR; PG8_WAIT_L(0); PG8_MMA(0, 0, At, B0); PG8_BAR; PG8_SCHED;
            PG8_LDB(B1, 0, 1); PG8_STAGE(PG8_SB(0, 0), b2, voffB);
            PG8_BAR; PG8_WAIT_L(0); PG8_MMA(0, 1, At, B1); PG8_BAR;
            PG8_LDA(At, 0, 1); PG8_STAGE(PG8_SA(0, 0), a2, voffA);
            PG8_BAR; PG8_WAIT_L(0); PG8_MMA(1, 0, At, B0); PG8_BAR; PG8_SCHED;
            PG8_STAGE(PG8_SB(0, 1), b2 + hstep, voffB);
            PG8_WAIT_V(6); PG8_BAR; PG8_MMA(1, 1, At, B1); PG8_BAR;
            PG8_LDB(B0, 1, 0); PG8_SCHED; PG8_LDA(At, 1, 0); PG8_STAGE(PG8_SA(0, 1), a2 + hstep, voffA);
            PG8_WAIT_L(8); PG8_BAR; PG8_WAIT_L(0); PG8_MMA(0, 0, At, B0); PG8_BAR; PG8_SCHED;
            PG8_LDB(B1, 1, 1); PG8_STAGE(PG8_SB(1, 0), b3, voffB);
            PG8_BAR; PG8_WAIT_L(0); PG8_MMA(0, 1, At, B1); PG8_BAR;
            PG8_LDA(At, 1, 1); PG8_STAGE(PG8_SA(1, 0), a3, voffA);
            PG8_BAR; PG8_WAIT_L(0); PG8_MMA(1, 0, At, B0); PG8_BAR; PG8_SCHED;
            PG8_STAGE(PG8_SB(1, 1), b3 + hstep, voffB);
            PG8_WAIT_V(6); PG8_BAR; PG8_MMA(1, 1, At, B1); PG8_BAR;
        }
        PG8_STAMP();
        if constexpr (!Epi::AFTER_DRAIN) { E(acc, cur, wr, wc, fr, fq); S.done(cur); }
        PG8_STAMP();
        if (!has_next) break;
#pragma unroll
        for (int a = 0; a < 2; ++a)
#pragma unroll
            for (int b = 0; b < 2; ++b)
#pragma unroll
                for (int m = 0; m < 4; ++m)
#pragma unroll
                    for (int n = 0; n < 2; ++n) acc[a][b][m][n] = (f32x4){0.f, 0.f, 0.f, 0.f};
        cur = nxt; cA = nA; cB = nB; ++ui;
    }
    PG8_WAIT_V(0);
    if (wr == 0) PG8_BAR;
    PG8_BAR;
    if constexpr (Epi::AFTER_DRAIN) { E.fused(acc, cur, wr, wc, fr, fq, lds, wid, lane); S.done(cur); }
    PG8_STAMP();
    if (STAMP && wid == 0) { stamps[lane] = lane < nts ? (((unsigned long long)(unsigned)ts_hi << 32) | (unsigned)ts_lo) : 0ull;
        if (lane == 62) stamps[62] = rt_entry; if (lane == 63) stamps[63] = (unsigned long long)wall_clock64(); }
#undef PG8_STAMP
#undef PG8_SA
#undef PG8_SB
#undef PG8_STAGE
#undef PG8_LDA
#undef PG8_LDB
#undef PG8_MMA
#undef PG8_WAIT_V
#undef PG8_WAIT_L
#undef PG8_BAR
#undef PG8_SCHED
}
}


#define XB_TMO      128
#define XB_XCNT(j)  (256  + 64 * (j))
#define XB_XSUB(j)  (1280 + 64 * (j))
#define XB_XGEN(j)  (2304 + 64 * (j))
#define XB_TOP      3328
#define XB_TOPGEN   3392
#define XCD_BAR_WORDS 3456
#define XB_SPIN_CAP (1u << 18)
#define LAS __attribute__((address_space(3)))

__device__ __forceinline__ unsigned xb_ld(unsigned* p)              { return __hip_atomic_load(p, __ATOMIC_RELAXED, __HIP_MEMORY_SCOPE_AGENT); }
__device__ __forceinline__ unsigned xb_add(unsigned* p, unsigned v) { return __hip_atomic_fetch_add(p, v, __ATOMIC_RELAXED, __HIP_MEMORY_SCOPE_AGENT); }
__device__ __forceinline__ unsigned xb_xcc_id() { return (unsigned)__builtin_amdgcn_s_getreg((3 << 11) | 20) & 0xFu; }
#define XB_SPIN(cond, bar) do { unsigned _sp = 0; while (cond) { __builtin_amdgcn_s_sleep(1); \
    if ((++_sp & 255u) == 0u) { if (xb_ld(&(bar)[XB_TMO])) break; if (_sp > XB_SPIN_CAP) { atomicAdd(&(bar)[XB_TMO], 1u); break; } } } } while (0)

struct XcdBarrier {
    unsigned* bar; unsigned x;
    volatile LAS unsigned* st;
};

__device__ __forceinline__ XcdBarrier xcd_barrier_post(unsigned* bar, volatile LAS unsigned* st) {
    XcdBarrier b; b.bar = bar; b.x = xb_xcc_id(); b.st = st;
    if (threadIdx.x == 0) (void)xb_add(&bar[XB_XCNT(b.x)], 1u);
    return b;
}
__device__ __forceinline__ void xcd_barrier_complete(unsigned* bar, unsigned x, unsigned& nloc, unsigned& nx) {
    const unsigned G = gridDim.x * gridDim.y * gridDim.z;
    unsigned sum, cnt, mine, sp = 0u;
    for (;;) {
        sum = 0u; cnt = 0u; mine = 0u;
#pragma unroll
        for (unsigned j = 0; j < 16; ++j) { const unsigned c = xb_ld(&bar[XB_XCNT(j)]); sum += c; cnt += (c > 0u) ? 1u : 0u; mine = (j == x) ? c : mine; }
        if (sum == G) break;
        __builtin_amdgcn_s_sleep(1);
        if ((++sp & 255u) == 0u) { if (xb_ld(&bar[XB_TMO])) break; if (sp > XB_SPIN_CAP) { atomicAdd(&bar[XB_TMO], 1u); break; } }
    }
    nloc = mine > 0u ? mine : 1u; nx = cnt > 0u ? cnt : 1u;
}

__device__ __forceinline__ void xcd_barrier(const XcdBarrier& b) {
    asm volatile("s_waitcnt vmcnt(0)" ::: "memory");
    __syncthreads();
    if (threadIdx.x == 0) {
        unsigned* bar = b.bar;
        __builtin_amdgcn_s_waitcnt(0);
        unsigned nloc = b.st[0], nx = b.st[1];
        if (nloc == 0u) { xcd_barrier_complete(bar, b.x, nloc, nx); b.st[0] = nloc; b.st[1] = nx; }
        const unsigned old = xb_add(&bar[XB_XSUB(b.x)], 1u);
        const unsigned gen = old / nloc;
        if (old + 1u == (gen + 1u) * nloc) {
            __builtin_amdgcn_fence(__ATOMIC_RELEASE, "agent");
            asm volatile("s_waitcnt vmcnt(0)" ::: "memory");
            const unsigned og = xb_add(&bar[XB_TOP], 1u);
            const unsigned tg = og / nx;
            if (og + 1u == (tg + 1u) * nx) xb_add(&bar[XB_TOPGEN], 1u);
            else XB_SPIN(xb_ld(&bar[XB_TOPGEN]) == tg, bar);
            __builtin_amdgcn_fence(__ATOMIC_ACQUIRE, "agent");
            xb_add(&bar[XB_XGEN(b.x)], 1u);
            asm volatile("s_waitcnt vmcnt(0)" ::: "memory");
        } else {
            XB_SPIN(xb_ld(&bar[XB_XGEN(b.x)]) == gen, bar);
            __builtin_amdgcn_fence(__ATOMIC_ACQUIRE, "agent");
            asm volatile("s_waitcnt vmcnt(0)" ::: "memory");
        }
    }
    __syncthreads();
}

typedef unsigned short u16;
typedef float f4 __attribute__((ext_vector_type(4)));
typedef unsigned u4 __attribute__((ext_vector_type(4)));
typedef unsigned u2 __attribute__((ext_vector_type(2)));
constexpr int DM = 2048, NBATCH = 4, SEQ = 2048, NTOK = NBATCH * SEQ;
constexpr int EVEN_IN = 5376, ODD_IN = 4096;
constexpr int E_U = 0, E_V = 1024, E_AG = 2048, E_Q = 3072, E_K = 4096, E_VV = 4224, E_BG = 4352;
constexpr int O_XC = 0, O_CG = 1024, O_XD = 2048, O_DG = 3072;
constexpr float DN_ALPHA = 1.681792830507429f;
constexpr float LN_EPS = 1e-5f;

__device__ __forceinline__ float bf2f(u16 b) { return __uint_as_float(((unsigned)b) << 16); }
__device__ __forceinline__ u16 f2bf(float f) { unsigned u = __float_as_uint(f); u += 0x7FFFu + ((u >> 16) & 1u); return (u16)(u >> 16); }
__device__ __forceinline__ unsigned pack2(float lo, float hi) { return (unsigned)f2bf(lo) | ((unsigned)f2bf(hi) << 16); }
__device__ __forceinline__ float lo16(unsigned w) { return __uint_as_float(w << 16); }
__device__ __forceinline__ float hi16(unsigned w) { return __uint_as_float(w & 0xffff0000u); }
__device__ __forceinline__ float silu_f(float x) { return x / (1.0f + __expf(-x)); }
__device__ __forceinline__ float sigmoid_f(float x) { return 1.0f / (1.0f + __expf(-x)); }
__device__ __forceinline__ float wave_sum(float v) {
#pragma unroll
    for (int o = 32; o > 0; o >>= 1) v += __shfl_xor(v, o);
    return v;
}
__device__ __forceinline__ float wave_max(float v) {
#pragma unroll
    for (int o = 32; o > 0; o >>= 1) v = fmaxf(v, __shfl_xor(v, o));
    return v;
}

struct Params {
    const float* x; const int* positions;
    const float* even_w_in; const float* even_a_ln_g; const float* even_a_ln_b; const float* even_a_ws; const float* even_a_bs;
    const float* even_b_sinks; const float* even_w_out; const float* even_ln_g; const float* even_ln_b;
    const float* odd_w_in; const float* odd_conv_w; const float* odd_conv_b; const float* odd_w_a; const float* odd_b_a;
    const float* odd_w_x; const float* odd_b_x; const float* odd_lam; const float* odd_w_pool; const float* odd_d_scale;
    const float* odd_w_out; const float* odd_ln_g; const float* odd_ln_b;
    float* out;
    u16* wt_in;
    u16* wt_out;
    u16* xb;
    u16* h;
    u16* mix;
    float* rope;
    float* vstat;
    unsigned* barw;
    u16* wpT;
    float* T0; float* T1; float* T2;
};

__device__ __forceinline__ void cvt_wT_tile(const float* __restrict__ W, u16* __restrict__ Wt, int K, int N, int tile, float* sm, int tid, int nthr) {
    const int ntn = N / 64; const int tk = tile / ntn, tn = tile % ntn;
    const float* src = W + (size_t)(tk * 64) * N + tn * 64;
    for (int i = tid; i < 64 * 16; i += nthr) { const int r = i >> 4, c4 = (i & 15) * 4; const f4 v = *(const f4*)(src + (size_t)r * N + c4);
        sm[r * 65 + c4] = v[0]; sm[r * 65 + c4 + 1] = v[1]; sm[r * 65 + c4 + 2] = v[2]; sm[r * 65 + c4 + 3] = v[3]; }
    __syncthreads();
    for (int i = tid; i < 64 * 8; i += nthr) { const int n = i & 63, k8 = (i >> 6) * 8;
        u4 w; w[0] = pack2(sm[(k8 + 0) * 65 + n], sm[(k8 + 1) * 65 + n]); w[1] = pack2(sm[(k8 + 2) * 65 + n], sm[(k8 + 3) * 65 + n]);
        w[2] = pack2(sm[(k8 + 4) * 65 + n], sm[(k8 + 5) * 65 + n]); w[3] = pack2(sm[(k8 + 6) * 65 + n], sm[(k8 + 7) * 65 + n]);
        *(u4*)(Wt + (size_t)(tn * 64 + n) * K + tk * 64 + k8) = w; }
    __syncthreads();
}
__device__ __forceinline__ void cvt_wT_all(const float* W, u16* Wt, int K, int N, float* sm, int bid, int nblk) {
    const int nt = (K / 64) * (N / 64);
    for (int t = bid; t < nt; t += nblk) cvt_wT_tile(W, Wt, K, N, t, sm, threadIdx.x, blockDim.x);
}

__device__ __forceinline__ void st_rope(const Params& p, int gt, int gn) {
    for (int i = gt; i < NTOK * 8; i += gn) { const int tok = i >> 3, f = i & 7;
        const float inv = exp2f(-(float)f * (18.931568569324174f / 8.0f));
        const float ang = (float)p.positions[tok] * inv;
        const double a = (double)ang; const double k = rint(a * 0.15915494309189535); const float r = (float)(a - k * 6.283185307179586);
        p.rope[tok * 16 + f] = __cosf(r); p.rope[tok * 16 + 8 + f] = __sinf(r); }
}
__device__ __forceinline__ void st_cvt_x(const float* __restrict__ x, u16* __restrict__ xb, int gt, int gn) {
    for (int i = gt; i < NTOK * DM / 4; i += gn) { const f4 v = ((const f4*)x)[i]; u2 w; w[0] = pack2(v[0], v[1]); w[1] = pack2(v[2], v[3]); ((u2*)xb)[i] = w; }
}

__device__ __forceinline__ void st_ln_rows(const float* z, const float* __restrict__ g, const float* __restrict__ b, float* xf, u16* __restrict__ xb, int gt, int gn) {
    const int lane = gt & 63; const int nw = gn >> 6;
    for (int row = gt >> 6; row < NTOK; row += nw) {
        f4 v[8]; float s = 0.f;
#pragma unroll
        for (int i = 0; i < 8; ++i) { v[i] = *(const f4*)(z + (size_t)row * DM + i * 256 + lane * 4); s += (v[i][0] + v[i][1]) + (v[i][2] + v[i][3]); }
        s = wave_sum(s); const float mu = s * (1.0f / DM); float q = 0.f;
#pragma unroll
        for (int i = 0; i < 8; ++i) { const f4 d = v[i] - mu; q += (d[0] * d[0] + d[1] * d[1]) + (d[2] * d[2] + d[3] * d[3]); }
        q = wave_sum(q); const float rstd = rsqrtf(q * (1.0f / DM) + LN_EPS);
#pragma unroll
        for (int i = 0; i < 8; ++i) { const int c = i * 256 + lane * 4; const f4 gg = *(const f4*)(g + c), bb = *(const f4*)(b + c);
            const f4 y = (v[i] - mu) * rstd * gg + bb; *(f4*)(xf + (size_t)row * DM + c) = y;
            u2 w; w[0] = pack2(y[0], y[1]); w[1] = pack2(y[2], y[3]); *(u2*)(xb + (size_t)row * DM + c) = w; }
    }
}

__device__ __forceinline__ void st_gmlp_stats(const Params& p, int gt, int gn) {
    const int lane = gt & 63; const int nw = gn >> 6;
    for (int tok = gt >> 6; tok < NTOK; tok += nw) {
        const u16* vp = p.h + (size_t)tok * EVEN_IN + E_V + lane * 16;
        float v[16]; const u4 a = *(const u4*)vp, b = *(const u4*)(vp + 8);
#pragma unroll
        for (int i = 0; i < 4; ++i) { v[2 * i] = lo16(a[i]); v[2 * i + 1] = hi16(a[i]); v[8 + 2 * i] = lo16(b[i]); v[8 + 2 * i + 1] = hi16(b[i]); }
        float s = 0.f;
#pragma unroll
        for (int i = 0; i < 16; ++i) s += v[i];
        s = wave_sum(s); const float mu = s * (1.0f / 1024.0f); float q = 0.f;
#pragma unroll
        for (int i = 0; i < 16; ++i) { const float d = v[i] - mu; q += d * d; }
        q = wave_sum(q);
        if (lane == 0) { p.vstat[tok * 2] = mu; p.vstat[tok * 2 + 1] = rsqrtf(q * (1.0f / 1024.0f) + LN_EPS); }
    }
}
__device__ __forceinline__ void st_gmlp_naive(const Params& p, int j, int gt, int gn) {
    const float* lng = p.even_a_ln_g + j * 1024; const float* lnb = p.even_a_ln_b + j * 1024;
    const float* ws = p.even_a_ws + (size_t)j * 8 * 128 * 128; const float* bs = p.even_a_bs + j * 8 * 128;
    for (int i = gt; i < NTOK * 1024; i += gn) { const int tok = i >> 10, c = i & 1023, g = c >> 7, tl = tok & 127, tok0 = tok - tl;
        float acc = bs[g * 128 + tl]; const float gg = lng[c], bb = lnb[c]; const float* wrow = ws + ((size_t)g * 128 + tl) * 128;
        for (int s = 0; s <= tl; ++s) { const float v = bf2f(p.h[(size_t)(tok0 + s) * EVEN_IN + E_V + c]);
            const float vl = (v - p.vstat[(tok0 + s) * 2]) * p.vstat[(tok0 + s) * 2 + 1] * gg + bb; acc += wrow[s] * vl; }
        const float u = bf2f(p.h[(size_t)tok * EVEN_IN + E_U + c]), ag = bf2f(p.h[(size_t)tok * EVEN_IN + E_AG + c]);
        p.mix[(size_t)tok * DM + c] = f2bf(u * acc * silu_f(ag)); }
}
__device__ __forceinline__ void st_attn_naive(const Params& p, int j, int gt, int gn) {
    const int lane = gt & 63; const int nw = gn >> 6;
    for (int item = gt >> 6; item < NTOK * 16; item += nw) { const int tok = item >> 4, hq = item & 15, hk = hq >> 3, tpos = tok & (SEQ - 1);
        float q[64]; const u16* qp = p.h + (size_t)tok * EVEN_IN + E_Q + hq * 64;
#pragma unroll
        for (int i = 0; i < 8; ++i) { const u4 w = *(const u4*)(qp + i * 8);
#pragma unroll
            for (int e = 0; e < 4; ++e) { q[i * 8 + 2 * e] = lo16(w[e]); q[i * 8 + 2 * e + 1] = hi16(w[e]); } }
        { const float* rp = p.rope + tok * 16;
#pragma unroll
          for (int f = 0; f < 8; ++f) { const float c = rp[f], s = rp[8 + f], t1 = q[f], t2 = q[8 + f]; q[f] = t1 * c - t2 * s; q[8 + f] = t2 * c + t1 * s; } }
        float sc[2];
#pragma unroll
        for (int half = 0; half < 2; ++half) { const int w = lane + half * 64; const int kp = tpos - w;
            float s = -INFINITY;
            if (kp >= 0) { const int kt = tok - w; const u16* kptr = p.h + (size_t)kt * EVEN_IN + E_K + hk * 64; const float* rp = p.rope + kt * 16; float kk[64];
#pragma unroll
                for (int i = 0; i < 8; ++i) { const u4 ww = *(const u4*)(kptr + i * 8);
#pragma unroll
                    for (int e = 0; e < 4; ++e) { kk[i * 8 + 2 * e] = lo16(ww[e]); kk[i * 8 + 2 * e + 1] = hi16(ww[e]); } }
#pragma unroll
                for (int f = 0; f < 8; ++f) { const float c = rp[f], sn = rp[8 + f], t1 = kk[f], t2 = kk[8 + f]; kk[f] = t1 * c - t2 * sn; kk[8 + f] = t2 * c + t1 * sn; }
                s = 0.f;
#pragma unroll
                for (int d = 0; d < 64; ++d) s += q[d] * kk[d];
                s *= 0.125f; }
            sc[half] = s; }
        const float sink = p.even_b_sinks[j * 16 + hq];
        const float m = fmaxf(wave_max(fmaxf(sc[0], sc[1])), sink);
        const float p0 = __expf(sc[0] - m), p1 = __expf(sc[1] - m);
        const float den = wave_sum(p0 + p1) + __expf(sink - m);
        float o = 0.f;
        for (int w = 0; w < 128; ++w) { const float pw = __shfl(w < 64 ? p0 : p1, w & 63); const int kp = tpos - w;
            if (kp >= 0) o += pw * bf2f(p.h[(size_t)(tok - w) * EVEN_IN + E_VV + hk * 64 + lane]); }
        const float bg = bf2f(p.h[(size_t)tok * EVEN_IN + E_BG + hq * 64 + lane]);
        p.mix[(size_t)tok * DM + 1024 + hq * 64 + lane] = f2bf(o / den * silu_f(bg)); }
}
__device__ __forceinline__ void st_lru_conv(const Params& p, int j, int gt, int gn) {
    const float* cw = p.odd_conv_w + j * 4 * 1024; const float* cb = p.odd_conv_b + j * 1024;
    for (int i = gt; i < NTOK * 1024; i += gn) { const int tok = i >> 10, c = i & 1023, tpos = tok & (SEQ - 1);
        float a = cb[c];
#pragma unroll
        for (int k = 0; k < 4; ++k) { const int d = 3 - k; if (tpos - d >= 0) a += cw[k * 1024 + c] * bf2f(p.h[(size_t)(tok - d) * ODD_IN + O_XC + c]); }
        p.T0[i] = a; }
}
__device__ __forceinline__ void st_lru_gates(const Params& p, int j, int gt, int gn) {
    const float* wa = p.odd_w_a + (size_t)j * 8 * 128 * 128; const float* wx = p.odd_w_x + (size_t)j * 8 * 128 * 128;
    for (int i = gt; i < NTOK * 1024; i += gn) { const int tok = i >> 10, c = i & 1023, hd = c >> 7, jj = c & 127;
        float ra = p.odd_b_a[j * 1024 + c], rx = p.odd_b_x[j * 1024 + c]; const float* xr = p.T0 + (size_t)tok * 1024 + hd * 128;
        for (int k = 0; k < 128; ++k) { const float xv = xr[k]; ra += xv * wa[((size_t)hd * 128 + k) * 128 + jj]; rx += xv * wx[((size_t)hd * 128 + k) * 128 + jj]; }
        const float r = sigmoid_f(ra), ig = sigmoid_f(rx); const float lam = p.odd_lam[j * 1024 + c];
        const float sp = log1pf(expf(-lam)); const float la = -8.0f * r * sp;
        p.T1[i] = expf(la); p.T2[i] = sqrtf(-expm1f(2.0f * la)) * (ig * p.T0[i]); }
}
__device__ __forceinline__ void st_lru_scan(const Params& p, int gt, int gn) {
    for (int i = gt; i < NBATCH * 1024; i += gn) { const int b = i >> 10, c = i & 1023; float hst = 0.f;
        for (int t = 0; t < SEQ; ++t) { const size_t tok = (size_t)b * SEQ + t; hst = p.T1[tok * 1024 + c] * hst + p.T2[tok * 1024 + c];
            p.mix[tok * DM + c] = f2bf(hst * silu_f(bf2f(p.h[tok * ODD_IN + O_CG + c]))); } }
}
__device__ __forceinline__ void st_pool_pre(const Params& p, int gt, int gn) {
    for (int i = gt; i < NTOK * 1024; i += gn) { const int tok = i >> 10, c = i & 1023, g = c >> 8, w = 2 << g, tpos = tok & (SEQ - 1);
        const int n = min(tpos + 1, w); float s = 0.f;
        for (int k = 0; k < n; ++k) s += bf2f(p.h[(size_t)(tok - k) * ODD_IN + O_XD + c]);
        p.T0[i] = s / (float)n - bf2f(p.h[(size_t)tok * ODD_IN + O_XD + c]); }
}
__device__ __forceinline__ void st_pool_mm(const Params& p, int j, int gt, int gn) {
    const float* wp = p.odd_w_pool + (size_t)j * 4 * 256 * 256;
    for (int i = gt; i < NTOK * 1024; i += gn) { const int tok = i >> 10, c = i & 1023, g = c >> 8, jj = c & 255;
        float a = 0.f; const float* pr = p.T0 + (size_t)tok * 1024 + g * 256;
        for (int k = 0; k < 256; ++k) a += pr[k] * wp[((size_t)g * 256 + k) * 256 + jj];
        a *= p.odd_d_scale[j * 1024 + c] * silu_f(bf2f(p.h[(size_t)tok * ODD_IN + O_DG + c]));
        p.mix[(size_t)tok * DM + 1024 + c] = f2bf(a); }
}

struct EpiH {
    static constexpr bool PERM = true, AFTER_DRAIN = false;
    u16* O; int ldc;
    __device__ __forceinline__ void operator()(const pg8::f32x4 (&acc)[2][2][4][2], const pg8::Unit& u, int wr, int wc, int fr, int fq) const {
        const int row0 = u.pm * 256 + wr * 64 + fr, col0 = u.pn * 256 + wc * 32 + 8 * fq;
#pragma unroll
        for (int ai = 0; ai < 2; ++ai)
#pragma unroll
            for (int m = 0; m < 4; ++m) { u16* rowp = O + (size_t)(row0 + ai * 128 + m * 16) * ldc + col0;
#pragma unroll
                for (int bj = 0; bj < 2; ++bj) { const pg8::f32x4 v0 = acc[ai][bj][m][0], v1 = acc[ai][bj][m][1];
                    u4 w; w[0] = pg8::cvt_pk_bf16(v0[0], v0[1]); w[1] = pg8::cvt_pk_bf16(v0[2], v0[3]); w[2] = pg8::cvt_pk_bf16(v1[0], v1[1]); w[3] = pg8::cvt_pk_bf16(v1[2], v1[3]);
                    *(u4*)(rowp + bj * 128) = w; } }
    }
};
struct EpiZ {
    static constexpr bool PERM = false, AFTER_DRAIN = false;
    const float* X; float* Z;
    __device__ __forceinline__ void operator()(const pg8::f32x4 (&acc)[2][2][4][2], const pg8::Unit& u, int wr, int wc, int fr, int fq) const {
        const int row0 = u.pm * 256 + wr * 64 + fr, col0 = u.pn * 256 + wc * 32 + 4 * fq;
#pragma unroll
        for (int ai = 0; ai < 2; ++ai)
#pragma unroll
            for (int m = 0; m < 4; ++m) { const size_t ro = (size_t)(row0 + ai * 128 + m * 16) * DM + col0;
#pragma unroll
                for (int bj = 0; bj < 2; ++bj)
#pragma unroll
                    for (int n = 0; n < 2; ++n) { const size_t o = ro + bj * 128 + n * 16; const pg8::f32x4 xv = *(const pg8::f32x4*)(X + o);
                        *(pg8::f32x4*)(Z + o) = xv * DN_ALPHA + acc[ai][bj][m][n]; } }
    }
};

typedef short bf8 __attribute__((ext_vector_type(8)));
#define MFMA16(P, Q, C) __builtin_amdgcn_mfma_f32_16x16x32_bf16((P), (Q), (C), 0, 0, 0)

constexpr int GM_LD = 136;
__device__ __forceinline__ void gmlp_unit(const Params& p, int j, int unit, unsigned char* lds, int tid) {
    u16* Wl = (u16*)lds; u16* Vt = Wl + 128 * GM_LD; float* stat = (float*)(Vt + 128 * GM_LD);
    const int lane = tid & 63, wid = tid >> 6, fr = lane & 15, fq = lane >> 4;
    const int g = unit & 7, tok0 = (unit >> 3) * 128;
    const float* lng = p.even_a_ln_g + j * 1024 + g * 128; const float* lnb = p.even_a_ln_b + j * 1024 + g * 128;
    const float* ws = p.even_a_ws + ((size_t)j * 8 + g) * 128 * 128; const float* bs = p.even_a_bs + (j * 8 + g) * 128;
    for (int r = 0; r < 16; ++r) { const int tl = wid * 16 + r; const u16* vp = p.h + (size_t)(tok0 + tl) * EVEN_IN + E_V + lane * 16;
        float v[16]; const u4 a = *(const u4*)vp, b = *(const u4*)(vp + 8);
#pragma unroll
        for (int i = 0; i < 4; ++i) { v[2 * i] = lo16(a[i]); v[2 * i + 1] = hi16(a[i]); v[8 + 2 * i] = lo16(b[i]); v[8 + 2 * i + 1] = hi16(b[i]); }
        float s = 0.f;
#pragma unroll
        for (int i = 0; i < 16; ++i) s += v[i];
        s = wave_sum(s); const float mu = s * (1.0f / 1024.0f); float q = 0.f;
#pragma unroll
        for (int i = 0; i < 16; ++i) { const float d = v[i] - mu; q += d * d; }
        q = wave_sum(q);
        if (lane == 0) { stat[tl * 2] = mu; stat[tl * 2 + 1] = rsqrtf(q * (1.0f / 1024.0f) + LN_EPS); } }
    for (int i = tid; i < 128 * 32; i += 512) { const int s4 = (i & 31) * 4, t = i >> 5; const f4 w = *(const f4*)(ws + t * 128 + s4);
        u2 o; o[0] = pack2(s4 <= t ? w[0] : 0.f, s4 + 1 <= t ? w[1] : 0.f); o[1] = pack2(s4 + 2 <= t ? w[2] : 0.f, s4 + 3 <= t ? w[3] : 0.f);
        *(u2*)(Wl + t * GM_LD + s4) = o; }
    __syncthreads();
    for (int i = tid; i < 128 * 16; i += 512) { const int d8 = (i & 15) * 8, s = i >> 4; const u4 w = *(const u4*)(p.h + (size_t)(tok0 + s) * EVEN_IN + E_V + g * 128 + d8);
        const float mu = stat[s * 2], rs = stat[s * 2 + 1];
#pragma unroll
        for (int e = 0; e < 4; ++e) { const float v0 = (lo16(w[e]) - mu) * rs * lng[d8 + 2 * e] + lnb[d8 + 2 * e], v1 = (hi16(w[e]) - mu) * rs * lng[d8 + 2 * e + 1] + lnb[d8 + 2 * e + 1];
            Vt[(d8 + 2 * e) * GM_LD + s] = f2bf(v0); Vt[(d8 + 2 * e + 1) * GM_LD + s] = f2bf(v1); } }
    __syncthreads();
    const int dt = wid; bf8 P[4];
#pragma unroll
    for (int ks = 0; ks < 4; ++ks) P[ks] = *(const bf8*)(Vt + (dt * 16 + fr) * GM_LD + ks * 32 + fq * 8);
#pragma unroll
    for (int tt = 0; tt < 8; ++tt) { f4 acc = {0.f, 0.f, 0.f, 0.f};
#pragma unroll
        for (int ks = 0; ks <= tt / 2; ++ks) { const bf8 Q = *(const bf8*)(Wl + (tt * 16 + fr) * GM_LD + ks * 32 + fq * 8); acc = MFMA16(P[ks], Q, acc); }
        const int tl = tt * 16 + fr, c = g * 128 + dt * 16 + fq * 4; const size_t hro = (size_t)(tok0 + tl) * EVEN_IN;
        const float bb = bs[tl]; const u2 uu = *(const u2*)(p.h + hro + E_U + c), gg = *(const u2*)(p.h + hro + E_AG + c);
        u2 o; o[0] = pack2(lo16(uu[0]) * (acc[0] + bb) * silu_f(lo16(gg[0])), hi16(uu[0]) * (acc[1] + bb) * silu_f(hi16(gg[0])));
        o[1] = pack2(lo16(uu[1]) * (acc[2] + bb) * silu_f(lo16(gg[1])), hi16(uu[1]) * (acc[3] + bb) * silu_f(hi16(gg[1])));
        *(u2*)(p.mix + (size_t)(tok0 + tl) * DM + c) = o; }
    __syncthreads();
}
__device__ __forceinline__ void st_gmlp_fast(const Params& p, int j, unsigned char* lds, int bid, int nblk, int tid) {
#pragma unroll 1
    for (int u = bid; u < 512; u += nblk) gmlp_unit(p, j, u, lds, tid);
}

constexpr int AT_KLD = 72, AT_VLD = 264, AT_HPU = 4;
__device__ __forceinline__ void attn_unit(const Params& p, int j, int unit, unsigned char* lds, int tid) {
    u16* Kl = (u16*)lds; u16* Vt = Kl + 256 * AT_KLD;
    const int lane = tid & 63, wid = tid >> 6, fr = lane & 15, fq = lane >> 4;
    const int hgrp = unit & 1, hk = (unit >> 1) & 1, nb = (unit >> 2) & 15, b = unit >> 6;
    const int tokq0 = b * SEQ + nb * 128;
    const int tokk0 = tokq0 - 128;
    for (int i = tid; i < 256 * 4; i += 512) { const int c4 = i & 3, key = i >> 2; u4 w0 = {0u, 0u, 0u, 0u}, w1 = {0u, 0u, 0u, 0u};
        if (nb > 0 || key >= 128) { const int tok = tokk0 + key; const u16* kp = p.h + (size_t)tok * EVEN_IN + E_K + hk * 64 + c4 * 16; w0 = *(const u4*)kp; w1 = *(const u4*)(kp + 8);
            if (c4 == 0) { const float* rp = p.rope + tok * 16; const f4 c0 = *(const f4*)rp, c1 = *(const f4*)(rp + 4), s0 = *(const f4*)(rp + 8), s1 = *(const f4*)(rp + 12);
                u4 n0, n1;
#pragma unroll
                for (int e = 0; e < 4; ++e) { const float ca = e < 2 ? c0[2 * e] : c1[2 * e - 4], cb = e < 2 ? c0[2 * e + 1] : c1[2 * e - 3], sa = e < 2 ? s0[2 * e] : s1[2 * e - 4], sb = e < 2 ? s0[2 * e + 1] : s1[2 * e - 3];
                    const float a1 = lo16(w0[e]), b1 = hi16(w0[e]), a2 = lo16(w1[e]), b2 = hi16(w1[e]);
                    n0[e] = pack2(a1 * ca - a2 * sa, b1 * cb - b2 * sb); n1[e] = pack2(a2 * ca + a1 * sa, b2 * cb + b1 * sb); }
                w0 = n0; w1 = n1; } }
        *(u4*)(Kl + key * AT_KLD + c4 * 16) = w0; *(u4*)(Kl + key * AT_KLD + c4 * 16 + 8) = w1; }
    for (int i = tid; i < 256 * 8; i += 512) { const int d8 = (i & 7) * 8, key = i >> 3; u4 w = {0u, 0u, 0u, 0u};
        if (nb > 0 || key >= 128) w = *(const u4*)(p.h + (size_t)(tokk0 + key) * EVEN_IN + E_VV + hk * 64 + d8);
#pragma unroll
        for (int e = 0; e < 4; ++e) { Vt[(d8 + 2 * e) * AT_VLD + key] = (u16)(w[e] & 0xffffu); Vt[(d8 + 2 * e + 1) * AT_VLD + key] = (u16)(w[e] >> 16); } }
    __syncthreads();
    const int qi = wid * 16 + fr, tokq = tokq0 + qi;
#pragma unroll 1
    for (int hh = 0; hh < AT_HPU; ++hh) { const int hq = hk * 8 + hgrp * AT_HPU + hh;
        bf8 Qf[2];
        { const u16* qp = p.h + (size_t)tokq * EVEN_IN + E_Q + hq * 64 + fq * 8; u4 w0 = *(const u4*)qp; const u4 w1 = *(const u4*)(qp + 32);
          float v[8];
#pragma unroll
          for (int e = 0; e < 4; ++e) { v[2 * e] = lo16(w0[e]); v[2 * e + 1] = hi16(w0[e]); }
          const float* rp = p.rope + tokq * 16; const f4 c0 = *(const f4*)rp, c1 = *(const f4*)(rp + 4), s0 = *(const f4*)(rp + 8), s1 = *(const f4*)(rp + 12);
          float cs[8], sn[8];
#pragma unroll
          for (int e = 0; e < 4; ++e) { cs[e] = c0[e]; cs[4 + e] = c1[e]; sn[e] = s0[e]; sn[4 + e] = s1[e]; }
#pragma unroll
          for (int e = 0; e < 8; ++e) { const float other = __shfl_xor(v[e], 16);
              const float rot = (fq == 0) ? (v[e] * cs[e] - other * sn[e]) : (v[e] * cs[e] + other * sn[e]); v[e] = (fq < 2) ? rot : v[e]; }
#pragma unroll
          for (int e = 0; e < 4; ++e) w0[e] = pack2(v[2 * e] * 0.125f, v[2 * e + 1] * 0.125f);
          u4 w1s;
#pragma unroll
          for (int e = 0; e < 4; ++e) w1s[e] = pack2(lo16(w1[e]) * 0.125f, hi16(w1[e]) * 0.125f);
          Qf[0] = __builtin_bit_cast(bf8, w0); Qf[1] = __builtin_bit_cast(bf8, w1s); }
        f4 S[9];
#pragma unroll
        for (int kt = 0; kt < 9; ++kt) { S[kt] = (f4){0.f, 0.f, 0.f, 0.f};
#pragma unroll
            for (int ks = 0; ks < 2; ++ks) { const bf8 Kf = *(const bf8*)(Kl + ((wid + kt) * 16 + fr) * AT_KLD + ks * 32 + fq * 8); S[kt] = MFMA16(Kf, Qf[ks], S[kt]); } }
        const float sink = p.even_b_sinks[j * 16 + hq];
        float m = sink;
        int qlo = (nb > 0) ? qi + 1 : max(qi + 1, 128); asm volatile("" : "+v"(qlo));
#pragma unroll
        for (int kt = 0; kt < 9; ++kt)
#pragma unroll
            for (int r = 0; r < 4; ++r) { const int kj = (wid + kt) * 16 + fq * 4 + r; const bool ok = (unsigned)(kj - qlo) <= (unsigned)(qi + 128 - qlo);
                S[kt][r] = ok ? S[kt][r] : -INFINITY; m = fmaxf(m, S[kt][r]); }
        m = fmaxf(m, __shfl_xor(m, 16)); m = fmaxf(m, __shfl_xor(m, 32));
        float l = 0.f;
#pragma unroll
        for (int kt = 0; kt < 9; ++kt)
#pragma unroll
            for (int r = 0; r < 4; ++r) { const float e = __expf(S[kt][r] - m); S[kt][r] = e; l += e; }
        l += __shfl_xor(l, 16); l += __shfl_xor(l, 32); l += __expf(sink - m);
        f4 O[4];
#pragma unroll
        for (int dt = 0; dt < 4; ++dt) O[dt] = (f4){0.f, 0.f, 0.f, 0.f};
#pragma unroll
        for (int pr = 0; pr < 5; ++pr) { const int ktA = 2 * pr, ktB = 2 * pr + 1;
            u4 pw; pw[0] = pack2(S[ktA][0], S[ktA][1]); pw[1] = pack2(S[ktA][2], S[ktA][3]);
            if (ktB < 9) { pw[2] = pack2(S[ktB < 9 ? ktB : 8][0], S[ktB < 9 ? ktB : 8][1]); pw[3] = pack2(S[ktB < 9 ? ktB : 8][2], S[ktB < 9 ? ktB : 8][3]); } else { pw[2] = 0u; pw[3] = 0u; }
            const bf8 Pf = __builtin_bit_cast(bf8, pw);
            const int tA = wid + ktA, tB = min(wid + ktB, 15);
#pragma unroll
            for (int dt = 0; dt < 4; ++dt) { const u16* vr = Vt + (dt * 16 + fr) * AT_VLD + fq * 4; const u2 va = *(const u2*)(vr + tA * 16), vb = *(const u2*)(vr + tB * 16);
                u4 vw; vw[0] = va[0]; vw[1] = va[1]; vw[2] = vb[0]; vw[3] = vb[1];
                O[dt] = MFMA16(__builtin_bit_cast(bf8, vw), Pf, O[dt]); } }
        const float inv = 1.0f / l;
#pragma unroll
        for (int dt = 0; dt < 4; ++dt) { const int c = hq * 64 + dt * 16 + fq * 4; const u2 gg = *(const u2*)(p.h + (size_t)tokq * EVEN_IN + E_BG + c);
            u2 o; o[0] = pack2(O[dt][0] * inv * silu_f(lo16(gg[0])), O[dt][1] * inv * silu_f(hi16(gg[0])));
            o[1] = pack2(O[dt][2] * inv * silu_f(lo16(gg[1])), O[dt][3] * inv * silu_f(hi16(gg[1])));
            *(u2*)(p.mix + (size_t)tokq * DM + 1024 + c) = o; }
    }
    __syncthreads();
}
__device__ __forceinline__ void st_attn_fast(const Params& p, int j, unsigned char* lds, int bid, int nblk, int tid) {
#pragma unroll 1
    for (int u = bid; u < 256; u += nblk) attn_unit(p, j, u, lds, tid);
}

__device__ __forceinline__ void lru_unit(const Params& p, int j, int unit, unsigned char* lds, int tid) {
    float* cwl = (float*)lds;
    float* agg = cwl + 640;
    const int lane = tid & 63, wid = tid >> 6, fr = lane & 15, fq = lane >> 4;
    const int b = unit >> 6, hd = (unit >> 3) & 7, cgp = unit & 7;
    const int ch0 = hd * 128 + cgp * 16;
    for (int i = tid; i < 640; i += 512) cwl[i] = (i < 512) ? p.odd_conv_w[j * 4096 + (i >> 7) * 1024 + hd * 128 + (i & 127)] : p.odd_conv_b[j * 1024 + hd * 128 + (i - 512)];
    bf8 WA[4], WX[4];
    { const float* wa = p.odd_w_a + ((size_t)j * 8 + hd) * 128 * 128 + cgp * 16 + fr; const float* wx = p.odd_w_x + ((size_t)j * 8 + hd) * 128 * 128 + cgp * 16 + fr;
#pragma unroll
      for (int ks = 0; ks < 4; ++ks) { u4 a, x;
#pragma unroll
          for (int e = 0; e < 4; ++e) { const int k = ks * 32 + fq * 8 + 2 * e; a[e] = pack2(wa[k * 128], wa[(k + 1) * 128]); x[e] = pack2(wx[k * 128], wx[(k + 1) * 128]); }
          WA[ks] = __builtin_bit_cast(bf8, a); WX[ks] = __builtin_bit_cast(bf8, x); } }
    float ba[4], bx[4], sp[4], cw4[4][4], cb4[4];
#pragma unroll
    for (int r = 0; r < 4; ++r) { const int c = ch0 + fq * 4 + r; ba[r] = p.odd_b_a[j * 1024 + c]; bx[r] = p.odd_b_x[j * 1024 + c]; sp[r] = -8.0f * log1pf(expf(-p.odd_lam[j * 1024 + c]));
        cb4[r] = p.odd_conv_b[j * 1024 + c];
#pragma unroll
        for (int k = 0; k < 4; ++k) cw4[k][r] = p.odd_conv_w[j * 4096 + k * 1024 + c]; }
    __syncthreads();
    const int seg0 = b * SEQ + wid * 256;
    float carry[4] = {0.f, 0.f, 0.f, 0.f}, aprod[4] = {1.f, 1.f, 1.f, 1.f};
#pragma unroll 1
    for (int pass = 0; pass < 2; ++pass) {
#pragma unroll 1
        for (int tl = 0; tl < 16; ++tl) {
            const int tokB = seg0 + tl * 16 + fr, tposB = tokB & (SEQ - 1);
            int loff = 0; asm volatile("" : "+v"(loff)); const float* cw = cwl + loff;
            const u16* xrow = p.h + (size_t)tokB * ODD_IN + O_XC + hd * 128;
            f4 accA = {0.f, 0.f, 0.f, 0.f}, accX = {0.f, 0.f, 0.f, 0.f};
#pragma unroll
            for (int ks = 0; ks < 4; ++ks) { const int kc = ks * 32 + fq * 8; float xv[8];
                { const f4 b0 = *(const f4*)(cw + 512 + kc), b1 = *(const f4*)(cw + 512 + kc + 4);
#pragma unroll
                  for (int e = 0; e < 4; ++e) { xv[e] = b0[e]; xv[4 + e] = b1[e]; } }
#pragma unroll
                for (int k = 0; k < 4; ++k) { u4 v = {0u, 0u, 0u, 0u}; if (tposB - 3 + k >= 0) v = *(const u4*)(xrow - (ptrdiff_t)(3 - k) * ODD_IN + kc);
                    const f4 w0 = *(const f4*)(cw + k * 128 + kc), w1 = *(const f4*)(cw + k * 128 + kc + 4);
#pragma unroll
                    for (int e = 0; e < 2; ++e) { xv[2 * e] += w0[2 * e] * lo16(v[e]); xv[2 * e + 1] += w0[2 * e + 1] * hi16(v[e]); xv[4 + 2 * e] += w1[2 * e] * lo16(v[2 + e]); xv[4 + 2 * e + 1] += w1[2 * e + 1] * hi16(v[2 + e]); } }
                u4 xw;
#pragma unroll
                for (int e = 0; e < 4; ++e) xw[e] = pack2(xv[2 * e], xv[2 * e + 1]);
                const bf8 Xf = __builtin_bit_cast(bf8, xw);
                accA = MFMA16(WA[ks], Xf, accA); accX = MFMA16(WX[ks], Xf, accX); }
            float xc4[4];
#pragma unroll
            for (int r = 0; r < 4; ++r) xc4[r] = cb4[r];
#pragma unroll
            for (int k = 0; k < 4; ++k) { u2 v = {0u, 0u}; if (tposB - 3 + k >= 0) v = *(const u2*)(xrow - (ptrdiff_t)(3 - k) * ODD_IN + cgp * 16 + fq * 4);
                xc4[0] += cw4[k][0] * lo16(v[0]); xc4[1] += cw4[k][1] * hi16(v[0]); xc4[2] += cw4[k][2] * lo16(v[1]); xc4[3] += cw4[k][3] * hi16(v[1]); }
            float hv[4];
#pragma unroll
            for (int r = 0; r < 4; ++r) { const float rg = sigmoid_f(accA[r] + ba[r]), ig = sigmoid_f(accX[r] + bx[r]); const float la = rg * sp[r];
                float a = expf(la); float bt = sqrtf(-expm1f(2.0f * la)) * (ig * xc4[r]);
#pragma unroll
                for (int d = 1; d < 16; d <<= 1) { const float ap = __shfl_up(a, d, 16), bp = __shfl_up(bt, d, 16); if (fr >= d) { bt = a * bp + bt; a = a * ap; } }
                const float h = a * carry[r] + bt; hv[r] = h;
                carry[r] = __shfl(h, 15, 16); aprod[r] *= __shfl(a, 15, 16); }
            if (pass == 1) { const u2 gg = *(const u2*)(p.h + (size_t)tokB * ODD_IN + O_CG + ch0 + fq * 4);
                u2 o; o[0] = pack2(hv[0] * silu_f(lo16(gg[0])), hv[1] * silu_f(hi16(gg[0]))); o[1] = pack2(hv[2] * silu_f(lo16(gg[1])), hv[3] * silu_f(hi16(gg[1])));
                *(u2*)(p.mix + (size_t)tokB * DM + ch0 + fq * 4) = o; }
        }
        if (pass == 0) {
            if (fr == 0) {
#pragma unroll
                for (int r = 0; r < 4; ++r) { agg[(wid * 16 + fq * 4 + r) * 2] = aprod[r]; agg[(wid * 16 + fq * 4 + r) * 2 + 1] = carry[r]; } }
            __syncthreads();
#pragma unroll
            for (int r = 0; r < 4; ++r) { float hin = 0.f;
                for (int s = 0; s < wid; ++s) hin = agg[(s * 16 + fq * 4 + r) * 2] * hin + agg[(s * 16 + fq * 4 + r) * 2 + 1];
                carry[r] = hin; }
        }
    }
    __syncthreads();
}
__device__ __forceinline__ void st_lru_fast(const Params& p, int j, unsigned char* lds, int bid, int nblk, int tid) {
#pragma unroll 1
    for (int u = bid; u < 256; u += nblk) lru_unit(p, j, u, lds, tid);
}

constexpr int PL_LD = 264;
__device__ __forceinline__ void pool_unit(const Params& p, int j, int unit, unsigned char* lds, int tid) {
    u16* Al = (u16*)lds;
    const int lane = tid & 63, wid = tid >> 6, fr = lane & 15, fq = lane >> 4;
    const int g = unit & 3, tok0 = (unit >> 2) * 128, w = 2 << g;
    {
        const int c8 = (tid & 31) * 8, seg = tid >> 5; const int t0 = tok0 + seg * 8, tpos0 = t0 & (SEQ - 1);
        const u16* base = p.h + O_XD + g * 256 + c8;
        float S[8];
#pragma unroll
        for (int e = 0; e < 8; ++e) S[e] = 0.f;
        for (int k = 1; k < w; ++k) if (tpos0 - k >= 0) { const u4 v = *(const u4*)(base + (size_t)(t0 - k) * ODD_IN);
#pragma unroll
            for (int e = 0; e < 4; ++e) { S[2 * e] += lo16(v[e]); S[2 * e + 1] += hi16(v[e]); } }
#pragma unroll 2
        for (int r = 0; r < 8; ++r) { const int tok = t0 + r, tpos = tpos0 + r; const u4 v = *(const u4*)(base + (size_t)tok * ODD_IN);
            const float rn = 1.0f / (float)min(tpos + 1, w); u4 o;
#pragma unroll
            for (int e = 0; e < 4; ++e) { const float x0 = lo16(v[e]), x1 = hi16(v[e]); S[2 * e] += x0; S[2 * e + 1] += x1; o[e] = pack2(S[2 * e] * rn - x0, S[2 * e + 1] * rn - x1); }
            *(u4*)(Al + (seg * 8 + r) * PL_LD + c8) = o;
            if (tpos - w + 1 >= 0) { const u4 q = *(const u4*)(base + (size_t)(tok - w + 1) * ODD_IN);
#pragma unroll
                for (int e = 0; e < 4; ++e) { S[2 * e] -= lo16(q[e]); S[2 * e + 1] -= hi16(q[e]); } } }
    }
    __syncthreads();
    const int wr = wid >> 2, wc = wid & 3;
    const u16* wp = p.wpT + ((size_t)g * 256 + wc * 64 + fr) * 256 + fq * 8;
    const u16* ap = Al + (wr * 64 + fr) * PL_LD + fq * 8;
    f4 acc[4][4];
#pragma unroll
    for (int nt = 0; nt < 4; ++nt)
#pragma unroll
        for (int mt = 0; mt < 4; ++mt) acc[nt][mt] = (f4){0.f, 0.f, 0.f, 0.f};
    bf8 Pc[4], Pn[4];
#pragma unroll
    for (int nt = 0; nt < 4; ++nt) Pc[nt] = *(const bf8*)(wp + nt * 16 * 256);
#pragma unroll
    for (int ks = 0; ks < 8; ++ks) {
        if (ks < 7) {
#pragma unroll
            for (int nt = 0; nt < 4; ++nt) Pn[nt] = *(const bf8*)(wp + nt * 16 * 256 + (ks + 1) * 32); }
        bf8 Q[4];
#pragma unroll
        for (int mt = 0; mt < 4; ++mt) Q[mt] = *(const bf8*)(ap + mt * 16 * PL_LD + ks * 32);
#pragma unroll
        for (int nt = 0; nt < 4; ++nt)
#pragma unroll
            for (int mt = 0; mt < 4; ++mt) acc[nt][mt] = MFMA16(Pc[nt], Q[mt], acc[nt][mt]);
#pragma unroll
        for (int nt = 0; nt < 4; ++nt) Pc[nt] = Pn[nt];
    }
#pragma unroll
    for (int nt = 0; nt < 4; ++nt) { const int c = g * 256 + wc * 64 + nt * 16 + fq * 4; const f4 ds = *(const f4*)(p.odd_d_scale + j * 1024 + c);
#pragma unroll
        for (int mt = 0; mt < 4; ++mt) { const int tok = tok0 + wr * 64 + mt * 16 + fr; const u2 gg = *(const u2*)(p.h + (size_t)tok * ODD_IN + O_DG + c);
            u2 o; o[0] = pack2(acc[nt][mt][0] * ds[0] * silu_f(lo16(gg[0])), acc[nt][mt][1] * ds[1] * silu_f(hi16(gg[0])));
            o[1] = pack2(acc[nt][mt][2] * ds[2] * silu_f(lo16(gg[1])), acc[nt][mt][3] * ds[3] * silu_f(hi16(gg[1])));
            *(u2*)(p.mix + (size_t)tok * DM + 1024 + c) = o; } }
    __syncthreads();
}
__device__ __forceinline__ void st_pool_fast(const Params& p, int j, unsigned char* lds, int bid, int nblk, int tid) {
#pragma unroll 1
    for (int u = bid; u < 256; u += nblk) pool_unit(p, j, u, lds, tid);
}
#ifndef MK_ONE_LAUNCH
#define MK_ONE_LAUNCH 1
#endif

constexpr int NSLOT = 1 + 4 * 8;
constexpr int LDS_BYTES = 131072 + 256;
__host__ __device__ inline bool slot_used(int s) { if (s == 0) return true; const int layer = (s - 1) >> 3, k = (s - 1) & 7; return k < 5; }

__device__ __forceinline__ void cvt_next_weights(const Params& p, int layer, float* sm, int bid_) {
    const int j = layer >> 1;
    const float* wo = (layer & 1) ? p.odd_w_out + (size_t)j * DM * DM : p.even_w_out + (size_t)j * DM * DM;
    cvt_wT_all(wo, p.wt_out, DM, DM, sm, bid_, gridDim.x);
    if (layer < 3) { const int nl = layer + 1, nj = nl >> 1;
        if (nl & 1) cvt_wT_all(p.odd_w_in + (size_t)nj * DM * ODD_IN, p.wt_in, DM, ODD_IN, sm, bid_, gridDim.x);
        else cvt_wT_all(p.even_w_in + (size_t)nj * DM * EVEN_IN, p.wt_in, DM, EVEN_IN, sm, bid_, gridDim.x); }
}

__device__ __forceinline__ void run_slot(const Params& p, int s, PG8_LAS unsigned char* lds, float* smf) {
    int tid_ = threadIdx.x; asm volatile("" : "+v"(tid_)); int bid_ = blockIdx.x; asm volatile("" : "+s"(bid_));
    const int gt = bid_ * 512 + tid_, gn = gridDim.x * 512;
    if (s == 0) { st_rope(p, gt, gn); st_cvt_x(p.x, p.xb, gt, gn); cvt_wT_all(p.even_w_in, p.wt_in, DM, EVEN_IN, smf, bid_, gridDim.x); return; }
    const int layer = (s - 1) >> 3, k = (s - 1) & 7, j = layer >> 1; const bool odd = layer & 1;
    const int gemm_z_slot = 3, ln_slot = 4;
    if (k == 0) for (int rep = 0; rep < REP_GH; ++rep) { const int N = odd ? ODD_IN : EVEN_IN; pg8::Gemm g{p.xb, p.wt_in, NTOK, N, DM}; pg8::StaticOrder S; S.init(NTOK, N, gridDim.x, bid_);
        EpiH E{p.h, N}; pg8::gemm_phase<EpiH, pg8::StaticOrder, false>(lds, g, S, E, nullptr); if (rep == REP_GH - 1) return; }
    if (k == gemm_z_slot) { pg8::Gemm g{p.mix, p.wt_out, NTOK, DM, DM}; pg8::StaticOrder S; S.init(NTOK, DM, gridDim.x, bid_);
        EpiZ E{layer == 0 ? p.x : p.out, p.out}; pg8::gemm_phase<EpiZ, pg8::StaticOrder, false>(lds, g, S, E, nullptr); return; }
    if (k == ln_slot) { const float* g = odd ? p.odd_ln_g + j * DM : p.even_ln_g + j * DM; const float* b = odd ? p.odd_ln_b + j * DM : p.even_ln_b + j * DM;
        st_ln_rows(p.out, g, b, p.out, p.xb, gt, gn); return; }
    if (!odd) {
        if (k == 1) { for (int rep = 0; rep < REP_CVT; ++rep) cvt_next_weights(p, layer, smf, bid_); }
        else if (k == 2) { for (int rep = 0; rep < REP_GMLP; ++rep) st_gmlp_fast(p, j, (unsigned char*)smf, bid_, gridDim.x, tid_); for (int rep = 0; rep < REP_ATTN; ++rep) st_attn_fast(p, j, (unsigned char*)smf, bid_, gridDim.x, tid_); }
    } else {
        if (k == 1) { cvt_next_weights(p, layer, smf, bid_);
            for (int g = 0; g < 4; ++g) cvt_wT_all(p.odd_w_pool + ((size_t)j * 4 + g) * 65536, p.wpT + g * 65536, 256, 256, smf, bid_, gridDim.x); }
        else if (k == 2) { for (int rep = 0; rep < REP_LRU; ++rep) st_lru_fast(p, j, (unsigned char*)smf, bid_, gridDim.x, tid_); for (int rep = 0; rep < REP_POOL; ++rep) st_pool_fast(p, j, (unsigned char*)smf, bid_, gridDim.x, tid_); }
    }
}

struct KArgs { Params p; int lo, hi; };
__global__ void __launch_bounds__(512, 2) k_mega(KArgs a) {
    extern __shared__ __attribute__((aligned(16))) unsigned char shm[];
    cg::grid_group grid = cg::this_grid();
    volatile LAS unsigned* st = (volatile LAS unsigned*)((LAS unsigned char*)shm + 131072);
    if (threadIdx.x < 4) st[threadIdx.x] = 0u;
    __syncthreads();
    XcdBarrier bar = xcd_barrier_post(a.p.barw, st);
    if (a.hi > 1000) grid.sync();
    for (int s = a.lo; s < a.hi; ++s) {
        if (!slot_used(s)) continue;
        run_slot(a.p, s, (PG8_LAS unsigned char*)shm, (float*)shm);
        if (s + 1 < a.hi) for (int rep = 0; rep < REP_SYNC; ++rep) xcd_barrier(bar);
    }
}

extern "C" void kernel_launch(void* const* d_in, const int* in_sizes, int n_in, void* d_out, int out_size, void* d_ws, size_t ws_size, hipStream_t stream) {
    static int grid = 0;
    if (grid == 0) {
        int dev = 0, cus = 0, per_cu = 0;
        hipGetDevice(&dev); hipDeviceGetAttribute(&cus, hipDeviceAttributeMultiprocessorCount, dev);
        if (hipFuncSetAttribute((const void*)k_mega, hipFuncAttributeMaxDynamicSharedMemorySize, LDS_BYTES) != hipSuccess) { fprintf(stderr, "hipFuncSetAttribute failed\n"); grid = -1; return; }
        hipOccupancyMaxActiveBlocksPerMultiprocessor(&per_cu, (const void*)k_mega, 512, LDS_BYTES);
        if (per_cu < 1) { fprintf(stderr, "occupancy query says %d\n", per_cu); per_cu = 1; }
        (void)hipGetLastError();
        grid = cus;
    }
    if (grid < 0) return;
    KArgs a; memset(&a, 0, sizeof(a));
    Params& p = a.p;
    p.x = (const float*)d_in[0]; p.positions = (const int*)d_in[1];
    p.even_w_in = (const float*)d_in[2]; p.even_a_ln_g = (const float*)d_in[3]; p.even_a_ln_b = (const float*)d_in[4]; p.even_a_ws = (const float*)d_in[5];
    p.even_a_bs = (const float*)d_in[6]; p.even_b_sinks = (const float*)d_in[7]; p.even_w_out = (const float*)d_in[8]; p.even_ln_g = (const float*)d_in[9];
    p.even_ln_b = (const float*)d_in[10]; p.odd_w_in = (const float*)d_in[11]; p.odd_conv_w = (const float*)d_in[12]; p.odd_conv_b = (const float*)d_in[13];
    p.odd_w_a = (const float*)d_in[14]; p.odd_b_a = (const float*)d_in[15]; p.odd_w_x = (const float*)d_in[16]; p.odd_b_x = (const float*)d_in[17];
    p.odd_lam = (const float*)d_in[18]; p.odd_w_pool = (const float*)d_in[19]; p.odd_d_scale = (const float*)d_in[20]; p.odd_w_out = (const float*)d_in[21];
    p.odd_ln_g = (const float*)d_in[22]; p.odd_ln_b = (const float*)d_in[23];
    p.out = (float*)d_out;
    unsigned char* w = (unsigned char*)d_ws; size_t off = 0;
    auto take = [&](size_t bytes) { unsigned char* r = w + off; off += (bytes + 255) & ~(size_t)255; return r; };
    p.wt_in = (u16*)take((size_t)EVEN_IN * DM * 2); p.wt_out = (u16*)take((size_t)DM * DM * 2); p.xb = (u16*)take((size_t)NTOK * DM * 2);
    p.h = (u16*)take((size_t)NTOK * EVEN_IN * 2); p.mix = (u16*)take((size_t)NTOK * DM * 2); p.rope = (float*)take((size_t)NTOK * 16 * 4);
    p.vstat = (float*)take((size_t)NTOK * 2 * 4); p.barw = (unsigned*)take((size_t)XCD_BAR_WORDS * 4); p.wpT = (u16*)take((size_t)4 * 65536 * 2);
    p.T0 = (float*)take((size_t)NTOK * 1024 * 4); p.T1 = (float*)take((size_t)NTOK * 1024 * 4); p.T2 = (float*)take((size_t)NTOK * 1024 * 4);
    if (off > ws_size) { fprintf(stderr, "workspace too small: need %zu have %zu\n", off, ws_size); return; }
    if (hipMemsetAsync(p.barw, 0, (size_t)XCD_BAR_WORDS * 4, stream) != hipSuccess) { fprintf(stderr, "memset failed\n"); return; }
#if MK_ONE_LAUNCH
    a.lo = 0; a.hi = NSLOT; void* args[] = {&a};
    hipError_t e = hipLaunchCooperativeKernel((const void*)k_mega, dim3(grid), dim3(512), args, LDS_BYTES, stream);
    if (e != hipSuccess) fprintf(stderr, "cooperative launch failed: %s (grid %d)\n", hipGetErrorString(e), grid);
#else
    for (int s = 0; s < NSLOT; ++s) { if (!slot_used(s)) continue; a.lo = s; a.hi = s + 1;
        hipLaunchKernelGGL(k_mega, dim3(grid), dim3(512), LDS_BYTES, stream, a); }
#endif
}
```

```cpp
#include <hip/hip_runtime.h>
#include <hip/hip_cooperative_groups.h>
#include <cstdio>
#include <cmath>
#include <cstring>
namespace cg = cooperative_groups;
#define REP_GH 1
#define REP_CVT 1
#define REP_GMLP 1
#define REP_ATTN 1
#define REP_LRU 1
#define REP_POOL 1
#define REP_SYNC 1
namespace pg8 {
#define PG8_LAS __attribute__((address_space(3)))
typedef unsigned short bf16_t;
typedef short bf16x8 __attribute__((ext_vector_type(8)));
typedef float f32x4 __attribute__((ext_vector_type(4)));
typedef unsigned u32x4 __attribute__((ext_vector_type(4)));
constexpr int BM = 256, BK = 64, HALF = 128, HTB = HALF * BK * 2  , STAGE_BYTES = 8 * HTB, NXCD = 8, WGM = 8;

__host__ __device__ __forceinline__ int lds_byte(int r, int c) { const int st = (r >> 4) * 2 + (c >> 5), rr = r & 15, cc = c & 31, ob = rr * 64 + cc * 2; return st * 1024 + (ob ^ (((ob >> 9) & 1) << 5)); }
__host__ __device__ __forceinline__ void stage_rc(int b, int& R, int& C) { const int st = b / 1024, sb = b % 1024, swz = sb ^ (((sb >> 9) & 1) << 5); R = (st >> 1) * 16 + swz / 64; C = (st & 1) * 32 + (swz % 64) / 2; }
__host__ __device__ __forceinline__ int perm32(int rho) { const int n = rho >> 4, i = rho & 15; return 8 * (i >> 2) + 4 * n + (i & 3); }

struct Unit { int pm, pn; };
struct Gemm { const bf16_t* A; const bf16_t* Bt; int M, N, K; };

struct StaticOrder {
    int nM, nN, nwg, G, c;
    __host__ __device__ void init(int M, int N, int G_, int c_) { nM = M / BM; nN = N / BM; nwg = nM * nN; G = G_; c = c_; }
    __host__ __device__ bool next(int i, Unit& u) const {
        const long L = (long)i * G + c; if (L >= nwg) return false;
        int wgid = (int)L; { const int q = nwg / NXCD, r = nwg % NXCD, xcd = wgid % NXCD, off = wgid / NXCD; wgid = (xcd < r ? xcd * (q + 1) : r * (q + 1) + (xcd - r) * q) + off; }
        const int nig = WGM * nN, gid = wgid / nig, fm = gid * WGM, gsz = (nM - fm) < WGM ? (nM - fm) : WGM;
        u.pm = fm + ((wgid % nig) % gsz); u.pn = (wgid % nig) / gsz; return true;
    }
    __device__ __forceinline__ void a_ready(const Unit&) const {}
    __device__ __forceinline__ void done(const Unit&) const {}
};
__device__ __forceinline__ unsigned cvt_pk_bf16(float lo, float hi) { unsigned r; asm volatile("v_cvt_pk_bf16_f32 %0, %1, %2" : "=v"(r) : "v"(lo), "v"(hi)); return r; }

template <class Epi, class Sched, bool STAMP = false>
__device__ __forceinline__ void gemm_phase(PG8_LAS unsigned char* lds, const Gemm g, const Sched& S, const Epi& E, unsigned long long* stamps) {
    int tid_ = threadIdx.x; asm volatile("" : "+v"(tid_));
    const int tid = tid_, wid = __builtin_amdgcn_readfirstlane(tid >> 6), lane = tid & 63, wr = wid >> 2, wc = wid & 3, fr = lane & 15, fq = lane >> 4;
    const int K = g.K, nt = K / BK;
    int ts_lo = 0, ts_hi = 0, nts = 0; const unsigned long long rt_entry = STAMP ? (unsigned long long)wall_clock64() : 0ull;
#define PG8_STAMP() do { if (STAMP && wid == 0 && nts < 64) { const unsigned long long _c = (unsigned long long)clock64(); \
        ts_lo = (lane == nts) ? (int)(unsigned)_c : ts_lo; ts_hi = (lane == nts) ? (int)(unsigned)(_c >> 32) : ts_hi; ++nts; } } while (0)
    PG8_STAMP();
    unsigned voffA[2], voffB[2];
#pragma unroll
    for (int i = 0; i < 2; ++i) { int R, C; stage_rc(tid * 16 + i * 8192, R, C); const int Rb = Epi::PERM ? ((R & ~31) + perm32(R & 31)) : R;
        voffA[i] = (unsigned)(R * K + C) * 2u; voffB[i] = (unsigned)(Rb * K + C) * 2u; }
    const size_t kstep = (size_t)(BK * 2);
    const size_t hstep = (size_t)HALF * K * 2;
    const size_t tstep = 2 * hstep;
    const unsigned ldsw = (unsigned)wid * 1024u;
    const int aoff = lds_byte(wr * 64 + fr, fq * 8), boff = lds_byte(wc * 32 + fr, fq * 8);
#define PG8_SA(b, h) (((b) * 2 + (h)) * HTB)
#define PG8_SB(b, h) ((4 + (b) * 2 + (h)) * HTB)
#define PG8_STAGE(bufoff, gbase, voff) do { _Pragma("unroll") for (int _i = 0; _i < 2; ++_i) \
        __builtin_amdgcn_global_load_lds((const unsigned*)((const char*)(gbase) + (voff)[_i]), (PG8_LAS unsigned*)(lds + (bufoff) + ldsw + _i * 8192), 16, 0, 0); } while (0)
#define PG8_LDA(dst, b, h) do { _Pragma("unroll") for (int m = 0; m < 4; ++m) _Pragma("unroll") for (int k = 0; k < 2; ++k) dst[m][k] = *(const PG8_LAS bf16x8*)(lds + PG8_SA(b, h) + aoff + m * 2048 + k * 1024); } while (0)
#define PG8_LDB(dst, b, h) do { _Pragma("unroll") for (int n = 0; n < 2; ++n) _Pragma("unroll") for (int k = 0; k < 2; ++k) dst[n][k] = *(const PG8_LAS bf16x8*)(lds + PG8_SB(b, h) + boff + n * 2048 + k * 1024); } while (0)
#define PG8_MMA(ai, bj, At, Bt) do { __builtin_amdgcn_s_setprio(1); _Pragma("unroll") for (int m = 0; m < 4; ++m) _Pragma("unroll") for (int n = 0; n < 2; ++n) _Pragma("unroll") for (int k = 0; k < 2; ++k) \
        acc[ai][bj][m][n] = __builtin_amdgcn_mfma_f32_16x16x32_bf16(Bt[n][k], At[m][k], acc[ai][bj][m][n], 0, 0, 0); __builtin_amdgcn_s_setprio(0); } while (0)
#define PG8_WAIT_V(n) asm volatile("s_waitcnt vmcnt(" #n ")" ::: "memory")
#define PG8_WAIT_L(n) asm volatile("s_waitcnt lgkmcnt(" #n ")" ::: "memory")
#define PG8_BAR __builtin_amdgcn_s_barrier()
#define PG8_SCHED __builtin_amdgcn_sched_barrier(0)
    Unit cur, nxt; int ui = 0;
    if (!S.next(0, cur)) return;
    f32x4 acc[2][2][4][2];
#pragma unroll
    for (int a = 0; a < 2; ++a)
#pragma unroll
        for (int b = 0; b < 2; ++b)
#pragma unroll
            for (int m = 0; m < 4; ++m)
#pragma unroll
                for (int n = 0; n < 2; ++n) acc[a][b][m][n] = (f32x4){0.f, 0.f, 0.f, 0.f};
    bf16x8 At[4][2], B0[2][2], B1[2][2];
    const char* cA = (const char*)g.A + (size_t)cur.pm * tstep; const char* cB = (const char*)g.Bt + (size_t)cur.pn * tstep;
    S.a_ready(cur);
    PG8_STAGE(PG8_SB(0, 0), cB, voffB); PG8_STAGE(PG8_SA(0, 0), cA, voffA); PG8_STAGE(PG8_SB(0, 1), cB + hstep, voffB); PG8_STAGE(PG8_SA(0, 1), cA + hstep, voffA);
    if (wr == 1) PG8_BAR;
    PG8_WAIT_V(4); PG8_BAR;
    PG8_STAGE(PG8_SB(1, 0), cB + kstep, voffB); PG8_STAGE(PG8_SA(1, 0), cA + kstep, voffA); PG8_STAGE(PG8_SB(1, 1), cB + hstep + kstep, voffB);
    PG8_WAIT_V(6); PG8_BAR;
    PG8_STAMP();
    for (;;) {
        const bool has_next = S.next(ui + 1, nxt);
        const char* nA = has_next ? (const char*)g.A + (size_t)nxt.pm * tstep : cA; const char* nB = has_next ? (const char*)g.Bt + (size_t)nxt.pn * tstep : cB;
        for (int t = 0; t < nt; t += 2) {
            const bool last = (t == nt - 2);
            const char* a1 = cA + (size_t)(t + 1) * kstep;
            const char* a2 = last ? nA : cA + (size_t)(t + 2) * kstep; const char* b2 = last ? nB : cB + (size_t)(t + 2) * kstep;
            const char* a3 = a2 + kstep; const char* b3 = b2 + kstep;
            if (last && has_next) S.a_ready(nxt);
            PG8_LDB(B0, 0, 0); PG8_SCHED; PG8_LDA(At, 0, 0); PG8_STAGE(PG8_SA(1, 1), a1 + hstep, voffA);
            PG8_WAIT_L(8); PG8_BAR; PG8_WAIT_L(0); PG8_MMA(0, 0, At, B0); PG8_BAR; PG8_SCHED;
            PG8_LDB(B1, 0, 1); PG8_STAGE(PG8_SB(0, 0), b2, voffB);
            PG8_BAR; PG8_WAIT_L(0); PG8_MMA(0, 1, At, B1); PG8_BAR;
            PG8_LDA(At, 0, 1); PG8_STAGE(PG8_SA(0, 0), a2, voffA);
            PG8_BAR; PG8_WAIT_L(0); PG8_MMA(1, 0, At, B0); PG8_BAR; PG8_SCHED;
            PG8_STAGE(PG8_SB(0, 1), b2 + hstep, voffB);
            PG8_WAIT_V(6); PG8_BAR; PG8_MMA(1, 1, At, B1); PG8_BAR;
            PG8_LDB(B0, 1, 0); PG8_SCHED; PG8_LDA(At, 1, 0); PG8_STAGE(PG8_SA(0, 1), a2 + hstep, voffA);
            PG8_WAIT_L(8); PG8_BAR; PG8_WAIT_L(0); PG8_MMA(0, 0, At, B0); PG8_BAR; PG8_SCHED;
            PG8_LDB(B1, 1, 1); PG8_STAGE(PG8_SB(1, 0), b3, voffB);
            PG8_BAR; PG8_WAIT_L(0); PG8_MMA(0, 1, At, B1); PG8_BAR;
            PG8_LDA(At, 1, 1); PG8_STAGE(PG8_SA(1, 0), a3, voffA);
            PG8_BAR; PG8_WAIT_L(0); PG8_MMA(1, 0, At, B0); PG8_BAR; PG8_SCHED;
            PG8_STAGE(PG8_SB(1, 1), b3 + hstep, voffB);
            PG8_WAIT_V(6); PG8_BAR; PG8_MMA(1, 1, At, B1); PG8_BAR;
        }
        PG8_STAMP();
        if constexpr (!Epi::AFTER_DRAIN) { E(acc, cur, wr, wc, fr, fq); S.done(cur); }
        PG8_STAMP();
        if (!has_next) break;
#pragma unroll
        for (int a = 0; a < 2; ++a)
#pragma unroll
            for (int b = 0; b < 2; ++b)
#pragma unroll
                for (int m = 0; m < 4; ++m)
#pragma unroll
                    for (int n = 0; n < 2; ++n) acc[a][b][m][n] = (f32x4){0.f, 0.f, 0.f, 0.f};
        cur = nxt; cA = nA; cB = nB; ++ui;
    }
    PG8_WAIT_V(0);
    if (wr == 0) PG8_BAR;
    PG8_BAR;
    if constexpr (Epi::AFTER_DRAIN) { E.fused(acc, cur, wr, wc, fr, fq, lds, wid, lane); S.done(cur); }
    PG8_STAMP();
    if (STAMP && wid == 0) { stamps[lane] = lane < nts ? (((unsigned long long)(unsigned)ts_hi << 32) | (unsigned)ts_lo) : 0ull;
        if (lane == 62) stamps[62] = rt_entry; if (lane == 63) stamps[63] = (unsigned long long)wall_clock64(); }
#undef PG8_STAMP
#undef PG8_SA
#undef PG8_SB
#undef PG8_STAGE
#undef PG8_LDA
#undef PG8_LDB
#undef PG8_MMA
#undef PG8_WAIT_V
#undef PG8_WAIT_L
#undef PG8_BAR
#undef PG8_SCHED
}
}


#define XB_TMO      128
#define XB_XCNT(j)  (256  + 64 * (j))
#define XB_XSUB(j)  (1280 + 64 * (j))
#define XB_XGEN(j)  (2304 + 64 * (j))
#define XB_TOP      3328
#define XB_TOPGEN   3392
#define XCD_BAR_WORDS 3456
#define XB_SPIN_CAP (1u << 18)
#define LAS __attribute__((address_space(3)))

__device__ __forceinline__ unsigned xb_ld(unsigned* p)              { return __hip_atomic_load(p, __ATOMIC_RELAXED, __HIP_MEMORY_SCOPE_AGENT); }
__device__ __forceinline__ unsigned xb_add(unsigned* p, unsigned v) { return __hip_atomic_fetch_add(p, v, __ATOMIC_RELAXED, __HIP_MEMORY_SCOPE_AGENT); }
__device__ __forceinline__ unsigned xb_xcc_id() { return (unsigned)__builtin_amdgcn_s_getreg((3 << 11) | 20) & 0xFu; }
#define XB_SPIN(cond, bar) do { unsigned _sp = 0; while (cond) { __builtin_amdgcn_s_sleep(1); \
    if ((++_sp & 255u) == 0u) { if (xb_ld(&(bar)[XB_TMO])) break; if (_sp > XB_SPIN_CAP) { atomicAdd(&(bar)[XB_TMO], 1u); break; } } } } while (0)

struct XcdBarrier {
    unsigned* bar; unsigned x;
    volatile LAS unsigned* st;
};

__device__ __forceinline__ XcdBarrier xcd_barrier_post(unsigned* bar, volatile LAS unsigned* st) {
    XcdBarrier b; b.bar = bar; b.x = xb_xcc_id(); b.st = st;
    if (threadIdx.x == 0) (void)xb_add(&bar[XB_XCNT(b.x)], 1u);
    return b;
}
__device__ __forceinline__ void xcd_barrier_complete(unsigned* bar, unsigned x, unsigned& nloc, unsigned& nx) {
    const unsigned G = gridDim.x * gridDim.y * gridDim.z;
    unsigned sum, cnt, mine, sp = 0u;
    for (;;) {
        sum = 0u; cnt = 0u; mine = 0u;
#pragma unroll
        for (unsigned j = 0; j < 16; ++j) { const unsigned c = xb_ld(&bar[XB_XCNT(j)]); sum += c; cnt += (c > 0u) ? 1u : 0u; mine = (j == x) ? c : mine; }
        if (sum == G) break;
        __builtin_amdgcn_s_sleep(1);
        if ((++sp & 255u) == 0u) { if (xb_ld(&bar[XB_TMO])) break; if (sp > XB_SPIN_CAP) { atomicAdd(&bar[XB_TMO], 1u); break; } }
    }
    nloc = mine > 0u ? mine : 1u; nx = cnt > 0u ? cnt : 1u;
}

__device__ __forceinline__ void xcd_barrier(const XcdBarrier& b) {
    asm volatile("s_waitcnt vmcnt(0)" ::: "memory");
    __syncthreads();
    if (threadIdx.x == 0) {
        unsigned* bar = b.bar;
        __builtin_amdgcn_s_waitcnt(0);
        unsigned nloc = b.st[0], nx = b.st[1];
        if (nloc == 0u) { xcd_barrier_complete(bar, b.x, nloc, nx); b.st[0] = nloc; b.st[1] = nx; }
        const unsigned old = xb_add(&bar[XB_XSUB(b.x)], 1u);
        const unsigned gen = old / nloc;
        if (old + 1u == (gen + 1u) * nloc) {
            __builtin_amdgcn_fence(__ATOMIC_RELEASE, "agent");
            asm volatile("s_waitcnt vmcnt(0)" ::: "memory");
            const unsigned og = xb_add(&bar[XB_TOP], 1u);
            const unsigned tg = og / nx;
            if (og + 1u == (tg + 1u) * nx) xb_add(&bar[XB_TOPGEN], 1u);
            else XB_SPIN(xb_ld(&bar[XB_TOPGEN]) == tg, bar);
            __builtin_amdgcn_fence(__ATOMIC_ACQUIRE, "agent");
            xb_add(&bar[XB_XGEN(b.x)], 1u);
            asm volatile("s_waitcnt vmcnt(0)" ::: "memory");
        } else {
            XB_SPIN(xb_ld(&bar[XB_XGEN(b.x)]) == gen, bar);
            __builtin_amdgcn_fence(__ATOMIC_ACQUIRE, "agent");
            asm volatile("s_waitcnt vmcnt(0)" ::: "memory");
        }
    }
    __syncthreads();
}

typedef unsigned short u16;
typedef float f4 __attribute__((ext_vector_type(4)));
typedef unsigned u4 __attribute__((ext_vector_type(4)));
typedef unsigned u2 __attribute__((ext_vector_type(2)));
constexpr int DM = 2048, NBATCH = 4, SEQ = 2048, NTOK = NBATCH * SEQ;
constexpr int EVEN_IN = 5376, ODD_IN = 4096;
constexpr int E_U = 0, E_V = 1024, E_AG = 2048, E_Q = 3072, E_K = 4096, E_VV = 4224, E_BG = 4352;
constexpr int O_XC = 0, O_CG = 1024, O_XD = 2048, O_DG = 3072;
constexpr float DN_ALPHA = 1.681792830507429f;
constexpr float LN_EPS = 1e-5f;

__device__ __forceinline__ float bf2f(u16 b) { return __uint_as_float(((unsigned)b) << 16); }
__device__ __forceinline__ u16 f2bf(float f) { unsigned u = __float_as_uint(f); u += 0x7FFFu + ((u >> 16) & 1u); return (u16)(u >> 16); }
__device__ __forceinline__ unsigned pack2(float lo, float hi) { return (unsigned)f2bf(lo) | ((unsigned)f2bf(hi) << 16); }
__device__ __forceinline__ float lo16(unsigned w) { return __uint_as_float(w << 16); }
__device__ __forceinline__ float hi16(unsigned w) { return __uint_as_float(w & 0xffff0000u); }
__device__ __forceinline__ float silu_f(float x) { return x / (1.0f + __expf(-x)); }
__device__ __forceinline__ float sigmoid_f(float x) { return 1.0f / (1.0f + __expf(-x)); }
__device__ __forceinline__ float wave_sum(float v) {
#pragma unroll
    for (int o = 32; o > 0; o >>= 1) v += __shfl_xor(v, o);
    return v;
}
__device__ __forceinline__ float wave_max(float v) {
#pragma unroll
    for (int o = 32; o > 0; o >>= 1) v = fmaxf(v, __shfl_xor(v, o));
    return v;
}

struct Params {
    const float* x; const int* positions;
    const float* even_w_in; const float* even_a_ln_g; const float* even_a_ln_b; const float* even_a_ws; const float* even_a_bs;
    const float* even_b_sinks; const float* even_w_out; const float* even_ln_g; const float* even_ln_b;
    const float* odd_w_in; const float* odd_conv_w; const float* odd_conv_b; const float* odd_w_a; const float* odd_b_a;
    const float* odd_w_x; const float* odd_b_x; const float* odd_lam; const float* odd_w_pool; const float* odd_d_scale;
    const float* odd_w_out; const float* odd_ln_g; const float* odd_ln_b;
    float* out;
    u16* wt_in;
    u16* wt_out;
    u16* xb;
    u16* h;
    u16* mix;
    float* rope;
    float* vstat;
    unsigned* barw;
    float* part;
    u16* wpT;
    u16* xcv;
};

__device__ __forceinline__ void cvt_wT_tile(const float* __restrict__ W, u16* __restrict__ Wt, int K, int N, int tile, float* sm, int tid, int nthr) {
    const int ntn = N / 64; const int tk = tile / ntn, tn = tile % ntn;
    const float* src = W + (size_t)(tk * 64) * N + tn * 64;
    for (int i = tid; i < 64 * 16; i += nthr) { const int r = i >> 4, c4 = (i & 15) * 4; const f4 v = *(const f4*)(src + (size_t)r * N + c4);
        sm[r * 65 + c4] = v[0]; sm[r * 65 + c4 + 1] = v[1]; sm[r * 65 + c4 + 2] = v[2]; sm[r * 65 + c4 + 3] = v[3]; }
    __syncthreads();
    for (int i = tid; i < 64 * 8; i += nthr) { const int n = i & 63, k8 = (i >> 6) * 8;
        u4 w; w[0] = pack2(sm[(k8 + 0) * 65 + n], sm[(k8 + 1) * 65 + n]); w[1] = pack2(sm[(k8 + 2) * 65 + n], sm[(k8 + 3) * 65 + n]);
        w[2] = pack2(sm[(k8 + 4) * 65 + n], sm[(k8 + 5) * 65 + n]); w[3] = pack2(sm[(k8 + 6) * 65 + n], sm[(k8 + 7) * 65 + n]);
        *(u4*)(Wt + (size_t)(tn * 64 + n) * K + tk * 64 + k8) = w; }
    __syncthreads();
}
__device__ __forceinline__ void cvt_wT_all(const float* W, u16* Wt, int K, int N, float* sm, int bid, int nblk) {
    const int nt = (K / 64) * (N / 64);
    for (int t = bid; t < nt; t += nblk) cvt_wT_tile(W, Wt, K, N, t, sm, threadIdx.x, blockDim.x);
}

__device__ __forceinline__ void st_rope(const Params& p, int gt, int gn) {
    for (int i = gt; i < NTOK * 8; i += gn) { const int tok = i >> 3, f = i & 7;
        const float inv = exp2f(-(float)f * (18.931568569324174f / 8.0f));
        const float ang = (float)p.positions[tok] * inv;
        const double a = (double)ang; const double k = rint(a * 0.15915494309189535); const float r = (float)(a - k * 6.283185307179586);
        p.rope[tok * 16 + f] = __cosf(r); p.rope[tok * 16 + 8 + f] = __sinf(r); }
}
__device__ __forceinline__ void st_cvt_x(const float* __restrict__ x, u16* __restrict__ xb, int gt, int gn) {
    for (int i = gt; i < NTOK * DM / 4; i += gn) { const f4 v = ((const f4*)x)[i]; u2 w; w[0] = pack2(v[0], v[1]); w[1] = pack2(v[2], v[3]); ((u2*)xb)[i] = w; }
}

__device__ __forceinline__ void st_ln_rows(const float* z, const float* __restrict__ g, const float* __restrict__ b, float* xf, u16* __restrict__ xb, int gt, int gn) {
    const int lane = gt & 63; const int nw = gn >> 6;
    for (int row = gt >> 6; row < NTOK; row += nw) {
        f4 v[8]; float s = 0.f;
#pragma unroll
        for (int i = 0; i < 8; ++i) { v[i] = *(const f4*)(z + (size_t)row * DM + i * 256 + lane * 4); s += (v[i][0] + v[i][1]) + (v[i][2] + v[i][3]); }
        s = wave_sum(s); const float mu = s * (1.0f / DM); float q = 0.f;
#pragma unroll
        for (int i = 0; i < 8; ++i) { const f4 d = v[i] - mu; q += (d[0] * d[0] + d[1] * d[1]) + (d[2] * d[2] + d[3] * d[3]); }
        q = wave_sum(q); const float rstd = rsqrtf(q * (1.0f / DM) + LN_EPS);
#pragma unroll
        for (int i = 0; i < 8; ++i) { const int c = i * 256 + lane * 4; const f4 gg = *(const f4*)(g + c), bb = *(const f4*)(b + c);
            const f4 y = (v[i] - mu) * rstd * gg + bb; *(f4*)(xf + (size_t)row * DM + c) = y;
            u2 w; w[0] = pack2(y[0], y[1]); w[1] = pack2(y[2], y[3]); *(u2*)(xb + (size_t)row * DM + c) = w; }
    }
}

struct EpiH {
    static constexpr bool PERM = true, AFTER_DRAIN = false;
    u16* O; int ldc;
    __device__ __forceinline__ void operator()(const pg8::f32x4 (&acc)[2][2][4][2], const pg8::Unit& u, int wr, int wc, int fr, int fq) const {
        const int row0 = u.pm * 256 + wr * 64 + fr, col0 = u.pn * 256 + wc * 32 + 8 * fq;
#pragma unroll
        for (int ai = 0; ai < 2; ++ai)
#pragma unroll
            for (int m = 0; m < 4; ++m) { u16* rowp = O + (size_t)(row0 + ai * 128 + m * 16) * ldc + col0;
#pragma unroll
                for (int bj = 0; bj < 2; ++bj) { const pg8::f32x4 v0 = acc[ai][bj][m][0], v1 = acc[ai][bj][m][1];
                    u4 w; w[0] = pg8::cvt_pk_bf16(v0[0], v0[1]); w[1] = pg8::cvt_pk_bf16(v0[2], v0[3]); w[2] = pg8::cvt_pk_bf16(v1[0], v1[1]); w[3] = pg8::cvt_pk_bf16(v1[2], v1[3]);
                    *(u4*)(rowp + bj * 128) = w; } }
    }
};
struct EpiZ {
    static constexpr bool PERM = false, AFTER_DRAIN = false;
    const float* X; float* Z;
    __device__ __forceinline__ void operator()(const pg8::f32x4 (&acc)[2][2][4][2], const pg8::Unit& u, int wr, int wc, int fr, int fq) const {
        const int row0 = u.pm * 256 + wr * 64 + fr, col0 = u.pn * 256 + wc * 32 + 4 * fq;
#pragma unroll
        for (int ai = 0; ai < 2; ++ai)
#pragma unroll
            for (int m = 0; m < 4; ++m) { const size_t ro = (size_t)(row0 + ai * 128 + m * 16) * DM + col0;
#pragma unroll
                for (int bj = 0; bj < 2; ++bj)
#pragma unroll
                    for (int n = 0; n < 2; ++n) { const size_t o = ro + bj * 128 + n * 16; const pg8::f32x4 xv = *(const pg8::f32x4*)(X + o);
                        *(pg8::f32x4*)(Z + o) = xv * DN_ALPHA + acc[ai][bj][m][n]; } }
    }
};

struct EpiLN {
    static constexpr bool PERM = false, AFTER_DRAIN = true;
    const float* X; float* XF; u16* XB; const float* g; const float* b; float* part; XcdBarrier bar;
    __device__ __forceinline__ void fused(pg8::f32x4 (&acc)[2][2][4][2], const pg8::Unit& u, int wr, int wc, int fr, int fq, PG8_LAS unsigned char* lds, int wid, int lane) const {
        PG8_LAS float* P = (PG8_LAS float*)lds;
        PG8_LAS float* S = P + 2048;
        const int tid = wid * 64 + lane;
        const int row0 = u.pm * 256 + wr * 64 + fr, col0 = u.pn * 256 + wc * 32 + 4 * fq;
#pragma unroll
        for (int ai = 0; ai < 2; ++ai)
#pragma unroll
            for (int m = 0; m < 4; ++m) { const size_t ro = (size_t)(row0 + ai * 128 + m * 16) * DM + col0; float s = 0.f, q = 0.f;
#pragma unroll
                for (int bj = 0; bj < 2; ++bj)
#pragma unroll
                    for (int n = 0; n < 2; ++n) { const pg8::f32x4 xv = *(const pg8::f32x4*)(X + ro + bj * 128 + n * 16); const pg8::f32x4 z = xv * DN_ALPHA + acc[ai][bj][m][n]; acc[ai][bj][m][n] = z;
                        s += (z[0] + z[1]) + (z[2] + z[3]); q += (z[0] * z[0] + z[1] * z[1]) + (z[2] * z[2] + z[3] * z[3]); }
                s += __shfl_xor(s, 16); s += __shfl_xor(s, 32); q += __shfl_xor(q, 16); q += __shfl_xor(q, 32);
                if (fq == 0) { const int r = ai * 128 + wr * 64 + m * 16 + fr; P[(r * 4 + wc) * 2] = s; P[(r * 4 + wc) * 2 + 1] = q; } }
        __syncthreads();
        if (tid < 256) { float s = 0.f, q = 0.f;
#pragma unroll
            for (int w = 0; w < 4; ++w) { s += P[(tid * 4 + w) * 2]; q += P[(tid * 4 + w) * 2 + 1]; }
            float2 v; v.x = s; v.y = q; *(float2*)(part + ((size_t)(u.pm * 256 + tid) * 8 + u.pn) * 2) = v; }
        xcd_barrier(bar);
        if (tid < 256) { float s = 0.f, q = 0.f; const float* pp = part + (size_t)(u.pm * 256 + tid) * 16;
#pragma unroll
            for (int w = 0; w < 4; ++w) { const pg8::f32x4 v = *(const pg8::f32x4*)(pp + w * 4); s += v[0] + v[2]; q += v[1] + v[3]; }
            const float mu = s * (1.0f / DM); const float var = fmaxf(q * (1.0f / DM) - mu * mu, 0.f);
            S[tid * 2] = mu; S[tid * 2 + 1] = rsqrtf(var + LN_EPS); }
        __syncthreads();
#pragma unroll
        for (int ai = 0; ai < 2; ++ai)
#pragma unroll
            for (int m = 0; m < 4; ++m) { const int r = ai * 128 + wr * 64 + m * 16 + fr; const float mu = S[r * 2], rs = S[r * 2 + 1];
                const size_t ro = (size_t)(row0 + ai * 128 + m * 16) * DM + col0;
#pragma unroll
                for (int bj = 0; bj < 2; ++bj)
#pragma unroll
                    for (int n = 0; n < 2; ++n) { const int c = col0 + bj * 128 + n * 16; const pg8::f32x4 gg = *(const pg8::f32x4*)(g + c), bb = *(const pg8::f32x4*)(b + c);
                        const pg8::f32x4 y = (acc[ai][bj][m][n] - mu) * rs * gg + bb; const size_t o = ro + bj * 128 + n * 16;
                        *(pg8::f32x4*)(XF + o) = y; u2 w; w[0] = pg8::cvt_pk_bf16(y[0], y[1]); w[1] = pg8::cvt_pk_bf16(y[2], y[3]); *(u2*)(XB + o) = w; } }
    }
};

typedef short bf8 __attribute__((ext_vector_type(8)));
#define MFMA16(P, Q, C) __builtin_amdgcn_mfma_f32_16x16x32_bf16((P), (Q), (C), 0, 0, 0)

constexpr int GM_LD = 136;
__device__ __forceinline__ void gmlp_unit(const Params& p, int j, int unit, unsigned char* lds, int tid) {
    u16* Wl = (u16*)lds; u16* Vt = Wl + 128 * GM_LD; float* stat = (float*)(Vt + 128 * GM_LD);
    const int lane = tid & 63, wid = tid >> 6, fr = lane & 15, fq = lane >> 4;
    const int g = unit & 7, tok0 = (unit >> 3) * 128;
    const float* lng = p.even_a_ln_g + j * 1024 + g * 128; const float* lnb = p.even_a_ln_b + j * 1024 + g * 128;
    const float* ws = p.even_a_ws + ((size_t)j * 8 + g) * 128 * 128; const float* bs = p.even_a_bs + (j * 8 + g) * 128;
    for (int r = 0; r < 16; ++r) { const int tl = wid * 16 + r; const u16* vp = p.h + (size_t)(tok0 + tl) * EVEN_IN + E_V + lane * 16;
        float v[16]; const u4 a = *(const u4*)vp, b = *(const u4*)(vp + 8);
#pragma unroll
        for (int i = 0; i < 4; ++i) { v[2 * i] = lo16(a[i]); v[2 * i + 1] = hi16(a[i]); v[8 + 2 * i] = lo16(b[i]); v[8 + 2 * i + 1] = hi16(b[i]); }
        float s = 0.f;
#pragma unroll
        for (int i = 0; i < 16; ++i) s += v[i];
        s = wave_sum(s); const float mu = s * (1.0f / 1024.0f); float q = 0.f;
#pragma unroll
        for (int i = 0; i < 16; ++i) { const float d = v[i] - mu; q += d * d; }
        q = wave_sum(q);
        if (lane == 0) { stat[tl * 2] = mu; stat[tl * 2 + 1] = rsqrtf(q * (1.0f / 1024.0f) + LN_EPS); } }
    for (int i = tid; i < 128 * 32; i += 512) { const int s4 = (i & 31) * 4, t = i >> 5; const f4 w = *(const f4*)(ws + t * 128 + s4);
        u2 o; o[0] = pack2(s4 <= t ? w[0] : 0.f, s4 + 1 <= t ? w[1] : 0.f); o[1] = pack2(s4 + 2 <= t ? w[2] : 0.f, s4 + 3 <= t ? w[3] : 0.f);
        *(u2*)(Wl + t * GM_LD + s4) = o; }
    __syncthreads();
    for (int i = tid; i < 128 * 16; i += 512) { const int d8 = (i & 15) * 8, s = i >> 4; const u4 w = *(const u4*)(p.h + (size_t)(tok0 + s) * EVEN_IN + E_V + g * 128 + d8);
        const float mu = stat[s * 2], rs = stat[s * 2 + 1];
#pragma unroll
        for (int e = 0; e < 4; ++e) { const float v0 = (lo16(w[e]) - mu) * rs * lng[d8 + 2 * e] + lnb[d8 + 2 * e], v1 = (hi16(w[e]) - mu) * rs * lng[d8 + 2 * e + 1] + lnb[d8 + 2 * e + 1];
            Vt[(d8 + 2 * e) * GM_LD + s] = f2bf(v0); Vt[(d8 + 2 * e + 1) * GM_LD + s] = f2bf(v1); } }
    __syncthreads();
    const int dt = wid; bf8 P[4];
#pragma unroll
    for (int ks = 0; ks < 4; ++ks) P[ks] = *(const bf8*)(Vt + (dt * 16 + fr) * GM_LD + ks * 32 + fq * 8);
#pragma unroll
    for (int tt = 0; tt < 8; ++tt) { f4 acc = {0.f, 0.f, 0.f, 0.f};
#pragma unroll
        for (int ks = 0; ks <= tt / 2; ++ks) { const bf8 Q = *(const bf8*)(Wl + (tt * 16 + fr) * GM_LD + ks * 32 + fq * 8); acc = MFMA16(P[ks], Q, acc); }
        const int tl = tt * 16 + fr, c = g * 128 + dt * 16 + fq * 4; const size_t hro = (size_t)(tok0 + tl) * EVEN_IN;
        const float bb = bs[tl]; const u2 uu = *(const u2*)(p.h + hro + E_U + c), gg = *(const u2*)(p.h + hro + E_AG + c);
        u2 o; o[0] = pack2(lo16(uu[0]) * (acc[0] + bb) * silu_f(lo16(gg[0])), hi16(uu[0]) * (acc[1] + bb) * silu_f(hi16(gg[0])));
        o[1] = pack2(lo16(uu[1]) * (acc[2] + bb) * silu_f(lo16(gg[1])), hi16(uu[1]) * (acc[3] + bb) * silu_f(hi16(gg[1])));
        *(u2*)(p.mix + (size_t)(tok0 + tl) * DM + c) = o; }
    __syncthreads();
}
__device__ __forceinline__ void st_gmlp_fast(const Params& p, int j, unsigned char* lds, int bid, int nblk, int tid) {
#pragma unroll 1
    for (int u = bid; u < 512; u += nblk) gmlp_unit(p, j, u, lds, tid);
}

constexpr int AT_KLD = 72, AT_VLD = 264, AT_HPU = 4;
__device__ __forceinline__ void attn_unit(const Params& p, int j, int unit, unsigned char* lds, int tid) {
    u16* Kl = (u16*)lds; u16* Vt = Kl + 256 * AT_KLD;
    const int lane = tid & 63, wid = tid >> 6, fr = lane & 15, fq = lane >> 4;
    const int hgrp = unit & 1, hk = (unit >> 1) & 1, nb = (unit >> 2) & 15, b = unit >> 6;
    const int tokq0 = b * SEQ + nb * 128;
    const int tokk0 = tokq0 - 128;
    for (int i = tid; i < 256 * 4; i += 512) { const int c4 = i & 3, key = i >> 2; u4 w0 = {0u, 0u, 0u, 0u}, w1 = {0u, 0u, 0u, 0u};
        if (nb > 0 || key >= 128) { const int tok = tokk0 + key; const u16* kp = p.h + (size_t)tok * EVEN_IN + E_K + hk * 64 + c4 * 16; w0 = *(const u4*)kp; w1 = *(const u4*)(kp + 8);
            if (c4 == 0) { const float* rp = p.rope + tok * 16; const f4 c0 = *(const f4*)rp, c1 = *(const f4*)(rp + 4), s0 = *(const f4*)(rp + 8), s1 = *(const f4*)(rp + 12);
                u4 n0, n1;
#pragma unroll
                for (int e = 0; e < 4; ++e) { const float ca = e < 2 ? c0[2 * e] : c1[2 * e - 4], cb = e < 2 ? c0[2 * e + 1] : c1[2 * e - 3], sa = e < 2 ? s0[2 * e] : s1[2 * e - 4], sb = e < 2 ? s0[2 * e + 1] : s1[2 * e - 3];
                    const float a1 = lo16(w0[e]), b1 = hi16(w0[e]), a2 = lo16(w1[e]), b2 = hi16(w1[e]);
                    n0[e] = pack2(a1 * ca - a2 * sa, b1 * cb - b2 * sb); n1[e] = pack2(a2 * ca + a1 * sa, b2 * cb + b1 * sb); }
                w0 = n0; w1 = n1; } }
        *(u4*)(Kl + key * AT_KLD + c4 * 16) = w0; *(u4*)(Kl + key * AT_KLD + c4 * 16 + 8) = w1; }
    for (int i = tid; i < 256 * 8; i += 512) { const int d8 = (i & 7) * 8, key = i >> 3; u4 w = {0u, 0u, 0u, 0u};
        if (nb > 0 || key >= 128) w = *(const u4*)(p.h + (size_t)(tokk0 + key) * EVEN_IN + E_VV + hk * 64 + d8);
#pragma unroll
        for (int e = 0; e < 4; ++e) { Vt[(d8 + 2 * e) * AT_VLD + key] = (u16)(w[e] & 0xffffu); Vt[(d8 + 2 * e + 1) * AT_VLD + key] = (u16)(w[e] >> 16); } }
    __syncthreads();
    const int qi = wid * 16 + fr, tokq = tokq0 + qi;
#pragma unroll 1
    for (int hh = 0; hh < AT_HPU; ++hh) { const int hq = hk * 8 + hgrp * AT_HPU + hh;
        bf8 Qf[2];
        { const u16* qp = p.h + (size_t)tokq * EVEN_IN + E_Q + hq * 64 + fq * 8; u4 w0 = *(const u4*)qp; const u4 w1 = *(const u4*)(qp + 32);
          float v[8];
#pragma unroll
          for (int e = 0; e < 4; ++e) { v[2 * e] = lo16(w0[e]); v[2 * e + 1] = hi16(w0[e]); }
          const float* rp = p.rope + tokq * 16; const f4 c0 = *(const f4*)rp, c1 = *(const f4*)(rp + 4), s0 = *(const f4*)(rp + 8), s1 = *(const f4*)(rp + 12);
          float cs[8], sn[8];
#pragma unroll
          for (int e = 0; e < 4; ++e) { cs[e] = c0[e]; cs[4 + e] = c1[e]; sn[e] = s0[e]; sn[4 + e] = s1[e]; }
#pragma unroll
          for (int e = 0; e < 8; ++e) { const float other = __shfl_xor(v[e], 16);
              const float rot = (fq == 0) ? (v[e] * cs[e] - other * sn[e]) : (v[e] * cs[e] + other * sn[e]); v[e] = (fq < 2) ? rot : v[e]; }
#pragma unroll
          for (int e = 0; e < 4; ++e) w0[e] = pack2(v[2 * e] * 0.125f, v[2 * e + 1] * 0.125f);
          u4 w1s;
#pragma unroll
          for (int e = 0; e < 4; ++e) w1s[e] = pack2(lo16(w1[e]) * 0.125f, hi16(w1[e]) * 0.125f);
          Qf[0] = __builtin_bit_cast(bf8, w0); Qf[1] = __builtin_bit_cast(bf8, w1s); }
        f4 S[9];
#pragma unroll
        for (int kt = 0; kt < 9; ++kt) { S[kt] = (f4){0.f, 0.f, 0.f, 0.f};
#pragma unroll
            for (int ks = 0; ks < 2; ++ks) { const bf8 Kf = *(const bf8*)(Kl + ((wid + kt) * 16 + fr) * AT_KLD + ks * 32 + fq * 8); S[kt] = MFMA16(Kf, Qf[ks], S[kt]); } }
        const float sink = p.even_b_sinks[j * 16 + hq];
        float m = sink;
        int qlo = (nb > 0) ? qi + 1 : max(qi + 1, 128); asm volatile("" : "+v"(qlo));
#pragma unroll
        for (int kt = 0; kt < 9; ++kt)
#pragma unroll
            for (int r = 0; r < 4; ++r) { const int kj = (wid + kt) * 16 + fq * 4 + r; const bool ok = (unsigned)(kj - qlo) <= (unsigned)(qi + 128 - qlo);
                S[kt][r] = ok ? S[kt][r] : -INFINITY; m = fmaxf(m, S[kt][r]); }
        m = fmaxf(m, __shfl_xor(m, 16)); m = fmaxf(m, __shfl_xor(m, 32));
        float l = 0.f;
#pragma unroll
        for (int kt = 0; kt < 9; ++kt)
#pragma unroll
            for (int r = 0; r < 4; ++r) { const float e = __expf(S[kt][r] - m); S[kt][r] = e; l += e; }
        l += __shfl_xor(l, 16); l += __shfl_xor(l, 32); l += __expf(sink - m);
        f4 O[4];
#pragma unroll
        for (int dt = 0; dt < 4; ++dt) O[dt] = (f4){0.f, 0.f, 0.f, 0.f};
#pragma unroll
        for (int pr = 0; pr < 5; ++pr) { const int ktA = 2 * pr, ktB = 2 * pr + 1;
            u4 pw; pw[0] = pack2(S[ktA][0], S[ktA][1]); pw[1] = pack2(S[ktA][2], S[ktA][3]);
            if (ktB < 9) { pw[2] = pack2(S[ktB < 9 ? ktB : 8][0], S[ktB < 9 ? ktB : 8][1]); pw[3] = pack2(S[ktB < 9 ? ktB : 8][2], S[ktB < 9 ? ktB : 8][3]); } else { pw[2] = 0u; pw[3] = 0u; }
            const bf8 Pf = __builtin_bit_cast(bf8, pw);
            const int tA = wid + ktA, tB = min(wid + ktB, 15);
#pragma unroll
            for (int dt = 0; dt < 4; ++dt) { const u16* vr = Vt + (dt * 16 + fr) * AT_VLD + fq * 4; const u2 va = *(const u2*)(vr + tA * 16), vb = *(const u2*)(vr + tB * 16);
                u4 vw; vw[0] = va[0]; vw[1] = va[1]; vw[2] = vb[0]; vw[3] = vb[1];
                O[dt] = MFMA16(__builtin_bit_cast(bf8, vw), Pf, O[dt]); } }
        const float inv = 1.0f / l;
#pragma unroll
        for (int dt = 0; dt < 4; ++dt) { const int c = hq * 64 + dt * 16 + fq * 4; const u2 gg = *(const u2*)(p.h + (size_t)tokq * EVEN_IN + E_BG + c);
            u2 o; o[0] = pack2(O[dt][0] * inv * silu_f(lo16(gg[0])), O[dt][1] * inv * silu_f(hi16(gg[0])));
            o[1] = pack2(O[dt][2] * inv * silu_f(lo16(gg[1])), O[dt][3] * inv * silu_f(hi16(gg[1])));
            *(u2*)(p.mix + (size_t)tokq * DM + 1024 + c) = o; }
    }
    __syncthreads();
}
__device__ __forceinline__ void st_attn_fast(const Params& p, int j, unsigned char* lds, int bid, int nblk, int tid) {
#pragma unroll 1
    for (int u = bid; u < 256; u += nblk) attn_unit(p, j, u, lds, tid);
}

__device__ __forceinline__ void st_xconv(const Params& p, int j, int gt, int gn) {
    const float* cw = p.odd_conv_w + j * 4096; const float* cb = p.odd_conv_b + j * 1024;
    for (int i = gt; i < NTOK * 128; i += gn) { const int tok = i >> 7, c8 = (i & 127) * 8, tpos = tok & (SEQ - 1);
        float xv[8]; { const f4 b0 = *(const f4*)(cb + c8), b1 = *(const f4*)(cb + c8 + 4);
#pragma unroll
            for (int e = 0; e < 4; ++e) { xv[e] = b0[e]; xv[4 + e] = b1[e]; } }
#pragma unroll
        for (int k = 0; k < 4; ++k) { u4 v = {0u, 0u, 0u, 0u}; if (tpos - 3 + k >= 0) v = *(const u4*)(p.h + (size_t)(tok - 3 + k) * ODD_IN + O_XC + c8);
            const f4 w0 = *(const f4*)(cw + k * 1024 + c8), w1 = *(const f4*)(cw + k * 1024 + c8 + 4);
#pragma unroll
            for (int e = 0; e < 2; ++e) { xv[2 * e] += w0[2 * e] * lo16(v[e]); xv[2 * e + 1] += w0[2 * e + 1] * hi16(v[e]); xv[4 + 2 * e] += w1[2 * e] * lo16(v[2 + e]); xv[4 + 2 * e + 1] += w1[2 * e + 1] * hi16(v[2 + e]); } }
        u4 o;
#pragma unroll
        for (int e = 0; e < 4; ++e) o[e] = pack2(xv[2 * e], xv[2 * e + 1]);
        *(u4*)(p.xcv + (size_t)tok * 1024 + c8) = o; }
}
constexpr int LR_CS = 545;
__device__ __forceinline__ void lru_unit(const Params& p, int j, int unit, unsigned char* lds, int tid) {
    float* Aq = (float*)lds; float* Bq = Aq + 16 * LR_CS; float* agg = Bq + 16 * LR_CS;
    float* carryq = agg + 16 * 32 * 2;
    const int lane = tid & 63, wid = tid >> 6, fr = lane & 15, fq = lane >> 4;
    const int b = unit >> 6, hd = (unit >> 3) & 7, cgp = unit & 7;
    const int ch0 = hd * 128 + cgp * 16;
    bf8 WA[4], WX[4];
    { const float* wa = p.odd_w_a + ((size_t)j * 8 + hd) * 128 * 128 + cgp * 16 + fr; const float* wx = p.odd_w_x + ((size_t)j * 8 + hd) * 128 * 128 + cgp * 16 + fr;
#pragma unroll
      for (int ks = 0; ks < 4; ++ks) { u4 a, x;
#pragma unroll
          for (int e = 0; e < 4; ++e) { const int k = ks * 32 + fq * 8 + 2 * e; a[e] = pack2(wa[k * 128], wa[(k + 1) * 128]); x[e] = pack2(wx[k * 128], wx[(k + 1) * 128]); }
          WA[ks] = __builtin_bit_cast(bf8, a); WX[ks] = __builtin_bit_cast(bf8, x); } }
    float ba[4], bx[4], sp[4];
#pragma unroll
    for (int r = 0; r < 4; ++r) { const int c = ch0 + fq * 4 + r; ba[r] = p.odd_b_a[j * 1024 + c]; bx[r] = p.odd_b_x[j * 1024 + c]; sp[r] = -8.0f * log1pf(expf(-p.odd_lam[j * 1024 + c])); }
    if (tid < 16) carryq[tid] = 0.f;
    const int sch = tid & 15, sseg = tid >> 4;
#pragma unroll 1
    for (int q = 0; q < 4; ++q) {
        const int tokq = b * SEQ + q * 512;
#pragma unroll
        for (int tl = 0; tl < 4; ++tl) { const int seg = wid * 4 + tl; const int tokB = tokq + seg * 16 + fr;
            const u16* xr = p.xcv + (size_t)tokB * 1024 + hd * 128;
            f4 accA = {0.f, 0.f, 0.f, 0.f}, accX = {0.f, 0.f, 0.f, 0.f};
#pragma unroll
            for (int ks = 0; ks < 4; ++ks) { const bf8 Xf = *(const bf8*)(xr + ks * 32 + fq * 8); accA = MFMA16(WA[ks], Xf, accA); accX = MFMA16(WX[ks], Xf, accX); }
            const u2 xo = *(const u2*)(xr + cgp * 16 + fq * 4); const float xc4[4] = {lo16(xo[0]), hi16(xo[0]), lo16(xo[1]), hi16(xo[1])};
#pragma unroll
            for (int r = 0; r < 4; ++r) { const float rg = sigmoid_f(accA[r] + ba[r]), ig = sigmoid_f(accX[r] + bx[r]); const float la = rg * sp[r];
                const float a = __expf(la); const float e = 2.0f * la;
                const float m2 = (e > -0.125f) ? -e * (1.0f + e * (0.5f + e * (0.16666667f + e * (0.041666668f + e * 0.008333334f)))) : 1.0f - __expf(e);
                const int idx = (fq * 4 + r) * LR_CS + seg * 17 + fr;
                Aq[idx] = a; Bq[idx] = sqrtf(m2) * (ig * xc4[r]); } }
        __syncthreads();
        { const int base = sch * LR_CS + sseg * 17; float A = 1.f, B = 0.f;
#pragma unroll
          for (int s = 0; s < 16; ++s) { const float a = Aq[base + s], bb = Bq[base + s]; B = a * B + bb; A *= a; }
          agg[(sch * 32 + sseg) * 2] = A; agg[(sch * 32 + sseg) * 2 + 1] = B;
          __syncthreads();
          float h = carryq[(q & 1) * 16 + sch];
          for (int s = 0; s < sseg; ++s) h = agg[(sch * 32 + s) * 2] * h + agg[(sch * 32 + s) * 2 + 1];
#pragma unroll
          for (int s = 0; s < 16; ++s) { h = Aq[base + s] * h + Bq[base + s]; Bq[base + s] = h; }
          if (sseg == 31) carryq[((q + 1) & 1) * 16 + sch] = h; }
        __syncthreads();
#pragma unroll
        for (int tl = 0; tl < 4; ++tl) { const int seg = wid * 4 + tl; const int tokB = tokq + seg * 16 + fr;
            const u2 gg = *(const u2*)(p.h + (size_t)tokB * ODD_IN + O_CG + ch0 + fq * 4);
            float hv[4];
#pragma unroll
            for (int r = 0; r < 4; ++r) hv[r] = Bq[(fq * 4 + r) * LR_CS + seg * 17 + fr];
            u2 o; o[0] = pack2(hv[0] * silu_f(lo16(gg[0])), hv[1] * silu_f(hi16(gg[0]))); o[1] = pack2(hv[2] * silu_f(lo16(gg[1])), hv[3] * silu_f(hi16(gg[1])));
            *(u2*)(p.mix + (size_t)tokB * DM + ch0 + fq * 4) = o; }
        __syncthreads();
    }
}
__device__ __forceinline__ void st_lru_fast(const Params& p, int j, unsigned char* lds, int bid, int nblk, int tid) {
#pragma unroll 1
    for (int u = bid; u < 256; u += nblk) lru_unit(p, j, u, lds, tid);
}

constexpr int PL_LD = 264;
__device__ __forceinline__ void pool_unit(const Params& p, int j, int unit, unsigned char* lds, int tid) {
    u16* Al = (u16*)lds;
    const int lane = tid & 63, wid = tid >> 6, fr = lane & 15, fq = lane >> 4;
    const int g = unit & 3, tok0 = (unit >> 2) * 128, w = 2 << g;
    {
        const int c8 = (tid & 31) * 8, seg = tid >> 5; const int t0 = tok0 + seg * 8, tpos0 = t0 & (SEQ - 1);
        const u16* base = p.h + O_XD + g * 256 + c8;
        float S[8];
#pragma unroll
        for (int e = 0; e < 8; ++e) S[e] = 0.f;
        for (int k = 1; k < w; ++k) if (tpos0 - k >= 0) { const u4 v = *(const u4*)(base + (size_t)(t0 - k) * ODD_IN);
#pragma unroll
            for (int e = 0; e < 4; ++e) { S[2 * e] += lo16(v[e]); S[2 * e + 1] += hi16(v[e]); } }
#pragma unroll 2
        for (int r = 0; r < 8; ++r) { const int tok = t0 + r, tpos = tpos0 + r; const u4 v = *(const u4*)(base + (size_t)tok * ODD_IN);
            const float rn = 1.0f / (float)min(tpos + 1, w); u4 o;
#pragma unroll
            for (int e = 0; e < 4; ++e) { const float x0 = lo16(v[e]), x1 = hi16(v[e]); S[2 * e] += x0; S[2 * e + 1] += x1; o[e] = pack2(S[2 * e] * rn - x0, S[2 * e + 1] * rn - x1); }
            *(u4*)(Al + (seg * 8 + r) * PL_LD + c8) = o;
            if (tpos - w + 1 >= 0) { const u4 q = *(const u4*)(base + (size_t)(tok - w + 1) * ODD_IN);
#pragma unroll
                for (int e = 0; e < 4; ++e) { S[2 * e] -= lo16(q[e]); S[2 * e + 1] -= hi16(q[e]); } } }
    }
    __syncthreads();
    const int wr = wid >> 2, wc = wid & 3;
    const u16* wp = p.wpT + ((size_t)g * 256 + wc * 64 + fr) * 256 + fq * 8;
    const u16* ap = Al + (wr * 64 + fr) * PL_LD + fq * 8;
    f4 acc[4][4];
#pragma unroll
    for (int nt = 0; nt < 4; ++nt)
#pragma unroll
        for (int mt = 0; mt < 4; ++mt) acc[nt][mt] = (f4){0.f, 0.f, 0.f, 0.f};
    bf8 Pc[4], Pn[4];
#pragma unroll
    for (int nt = 0; nt < 4; ++nt) Pc[nt] = *(const bf8*)(wp + nt * 16 * 256);
#pragma unroll
    for (int ks = 0; ks < 8; ++ks) {
        if (ks < 7) {
#pragma unroll
            for (int nt = 0; nt < 4; ++nt) Pn[nt] = *(const bf8*)(wp + nt * 16 * 256 + (ks + 1) * 32); }
        bf8 Q[4];
#pragma unroll
        for (int mt = 0; mt < 4; ++mt) Q[mt] = *(const bf8*)(ap + mt * 16 * PL_LD + ks * 32);
#pragma unroll
        for (int nt = 0; nt < 4; ++nt)
#pragma unroll
            for (int mt = 0; mt < 4; ++mt) acc[nt][mt] = MFMA16(Pc[nt], Q[mt], acc[nt][mt]);
#pragma unroll
        for (int nt = 0; nt < 4; ++nt) Pc[nt] = Pn[nt];
    }
#pragma unroll
    for (int nt = 0; nt < 4; ++nt) { const int c = g * 256 + wc * 64 + nt * 16 + fq * 4; const f4 ds = *(const f4*)(p.odd_d_scale + j * 1024 + c);
#pragma unroll
        for (int mt = 0; mt < 4; ++mt) { const int tok = tok0 + wr * 64 + mt * 16 + fr; const u2 gg = *(const u2*)(p.h + (size_t)tok * ODD_IN + O_DG + c);
            u2 o; o[0] = pack2(acc[nt][mt][0] * ds[0] * silu_f(lo16(gg[0])), acc[nt][mt][1] * ds[1] * silu_f(hi16(gg[0])));
            o[1] = pack2(acc[nt][mt][2] * ds[2] * silu_f(lo16(gg[1])), acc[nt][mt][3] * ds[3] * silu_f(hi16(gg[1])));
            *(u2*)(p.mix + (size_t)tok * DM + 1024 + c) = o; } }
    __syncthreads();
}
__device__ __forceinline__ void st_pool_fast(const Params& p, int j, unsigned char* lds, int bid, int nblk, int tid) {
#pragma unroll 1
    for (int u = bid; u < 256; u += nblk) pool_unit(p, j, u, lds, tid);
}
#ifndef MK_ONE_LAUNCH
#define MK_ONE_LAUNCH 1
#endif

constexpr int NSLOT = 1 + 4 * 8;
constexpr int LDS_BYTES = 131072 + 256;
__host__ __device__ inline bool slot_used(int s, int fuse) { if (s == 0) return true; const int k = (s - 1) & 7; return fuse ? (k < 4) : (k < 5); }

__device__ __forceinline__ void cvt_next_weights(const Params& p, int layer, float* sm, int bid_) {
    const int j = layer >> 1;
    const float* wo = (layer & 1) ? p.odd_w_out + (size_t)j * DM * DM : p.even_w_out + (size_t)j * DM * DM;
    cvt_wT_all(wo, p.wt_out, DM, DM, sm, bid_, gridDim.x);
    if (layer < 3) { const int nl = layer + 1, nj = nl >> 1;
        if (nl & 1) cvt_wT_all(p.odd_w_in + (size_t)nj * DM * ODD_IN, p.wt_in, DM, ODD_IN, sm, bid_, gridDim.x);
        else cvt_wT_all(p.even_w_in + (size_t)nj * DM * EVEN_IN, p.wt_in, DM, EVEN_IN, sm, bid_, gridDim.x); }
}

__device__ __forceinline__ void run_slot(const Params& p, int s, PG8_LAS unsigned char* lds, float* smf, const XcdBarrier& bar, int fuse) {
    int tid_ = threadIdx.x; asm volatile("" : "+v"(tid_)); int bid_ = blockIdx.x; asm volatile("" : "+s"(bid_));
    const int gt = bid_ * 512 + tid_, gn = gridDim.x * 512;
    if (s == 0) { st_rope(p, gt, gn); st_cvt_x(p.x, p.xb, gt, gn); cvt_wT_all(p.even_w_in, p.wt_in, DM, EVEN_IN, smf, bid_, gridDim.x); return; }
    const int layer = (s - 1) >> 3, k = (s - 1) & 7, j = layer >> 1; const bool odd = layer & 1;
    const int gemm_z_slot = 3, ln_slot = 4;
    if (k == 0) for (int rep = 0; rep < REP_GH; ++rep) { const int N = odd ? ODD_IN : EVEN_IN; pg8::Gemm g{p.xb, p.wt_in, NTOK, N, DM}; pg8::StaticOrder S; S.init(NTOK, N, gridDim.x, bid_);
        EpiH E{p.h, N}; pg8::gemm_phase<EpiH, pg8::StaticOrder, false>(lds, g, S, E, nullptr); if (rep == REP_GH - 1) return; }
    if (k == gemm_z_slot && fuse) { pg8::Gemm g{p.mix, p.wt_out, NTOK, DM, DM}; pg8::StaticOrder S; S.init(NTOK, DM, gridDim.x, bid_);
        EpiLN E{layer == 0 ? p.x : p.out, p.out, p.xb, odd ? p.odd_ln_g + j * DM : p.even_ln_g + j * DM, odd ? p.odd_ln_b + j * DM : p.even_ln_b + j * DM, p.part, bar};
        pg8::gemm_phase<EpiLN, pg8::StaticOrder, false>(lds, g, S, E, nullptr); return; }
    if (k == gemm_z_slot) { pg8::Gemm g{p.mix, p.wt_out, NTOK, DM, DM}; pg8::StaticOrder S; S.init(NTOK, DM, gridDim.x, bid_);
        EpiZ E{layer == 0 ? p.x : p.out, p.out}; pg8::gemm_phase<EpiZ, pg8::StaticOrder, false>(lds, g, S, E, nullptr); return; }
    if (k == ln_slot) { const float* g = odd ? p.odd_ln_g + j * DM : p.even_ln_g + j * DM; const float* b = odd ? p.odd_ln_b + j * DM : p.even_ln_b + j * DM;
        st_ln_rows(p.out, g, b, p.out, p.xb, gt, gn); return; }
    if (!odd) {
        if (k == 1) { for (int rep = 0; rep < REP_CVT; ++rep) cvt_next_weights(p, layer, smf, bid_); }
        else if (k == 2) { for (int rep = 0; rep < REP_GMLP; ++rep) st_gmlp_fast(p, j, (unsigned char*)smf, bid_, gridDim.x, tid_); for (int rep = 0; rep < REP_ATTN; ++rep) st_attn_fast(p, j, (unsigned char*)smf, bid_, gridDim.x, tid_); }
    } else {
        if (k == 1) { st_xconv(p, j, gt, gn); cvt_next_weights(p, layer, smf, bid_);
            for (int g = 0; g < 4; ++g) cvt_wT_all(p.odd_w_pool + ((size_t)j * 4 + g) * 65536, p.wpT + g * 65536, 256, 256, smf, bid_, gridDim.x); }
        else if (k == 2) { for (int rep = 0; rep < REP_LRU; ++rep) st_lru_fast(p, j, (unsigned char*)smf, bid_, gridDim.x, tid_); for (int rep = 0; rep < REP_POOL; ++rep) st_pool_fast(p, j, (unsigned char*)smf, bid_, gridDim.x, tid_); }
    }
}

struct KArgs { Params p; int lo, hi, fuse, pad; };
__global__ void __launch_bounds__(512, 2) k_mega(KArgs a) {
    extern __shared__ __attribute__((aligned(16))) unsigned char shm[];
    cg::grid_group grid = cg::this_grid();
    volatile LAS unsigned* st = (volatile LAS unsigned*)((LAS unsigned char*)shm + 131072);
    if (threadIdx.x < 4) st[threadIdx.x] = 0u;
    __syncthreads();
    XcdBarrier bar = xcd_barrier_post(a.p.barw, st);
    if (a.hi > 1000) grid.sync();
    for (int s = a.lo; s < a.hi; ++s) {
        if (!slot_used(s, a.fuse)) continue;
        run_slot(a.p, s, (PG8_LAS unsigned char*)shm, (float*)shm, bar, a.fuse);
        if (s + 1 < a.hi) for (int rep = 0; rep < REP_SYNC; ++rep) xcd_barrier(bar);
    }
}

extern "C" void kernel_launch(void* const* d_in, const int* in_sizes, int n_in, void* d_out, int out_size, void* d_ws, size_t ws_size, hipStream_t stream) {
    static int grid = 0;
    if (grid == 0) {
        int dev = 0, cus = 0, per_cu = 0;
        hipGetDevice(&dev); hipDeviceGetAttribute(&cus, hipDeviceAttributeMultiprocessorCount, dev);
        if (hipFuncSetAttribute((const void*)k_mega, hipFuncAttributeMaxDynamicSharedMemorySize, LDS_BYTES) != hipSuccess) { fprintf(stderr, "hipFuncSetAttribute failed\n"); grid = -1; return; }
        hipOccupancyMaxActiveBlocksPerMultiprocessor(&per_cu, (const void*)k_mega, 512, LDS_BYTES);
        if (per_cu < 1) { fprintf(stderr, "occupancy query says %d\n", per_cu); per_cu = 1; }
        (void)hipGetLastError();
        grid = cus;
    }
    if (grid < 0) return;
    KArgs a; memset(&a, 0, sizeof(a));
    Params& p = a.p;
    p.x = (const float*)d_in[0]; p.positions = (const int*)d_in[1];
    p.even_w_in = (const float*)d_in[2]; p.even_a_ln_g = (const float*)d_in[3]; p.even_a_ln_b = (const float*)d_in[4]; p.even_a_ws = (const float*)d_in[5];
    p.even_a_bs = (const float*)d_in[6]; p.even_b_sinks = (const float*)d_in[7]; p.even_w_out = (const float*)d_in[8]; p.even_ln_g = (const float*)d_in[9];
    p.even_ln_b = (const float*)d_in[10]; p.odd_w_in = (const float*)d_in[11]; p.odd_conv_w = (const float*)d_in[12]; p.odd_conv_b = (const float*)d_in[13];
    p.odd_w_a = (const float*)d_in[14]; p.odd_b_a = (const float*)d_in[15]; p.odd_w_x = (const float*)d_in[16]; p.odd_b_x = (const float*)d_in[17];
    p.odd_lam = (const float*)d_in[18]; p.odd_w_pool = (const float*)d_in[19]; p.odd_d_scale = (const float*)d_in[20]; p.odd_w_out = (const float*)d_in[21];
    p.odd_ln_g = (const float*)d_in[22]; p.odd_ln_b = (const float*)d_in[23];
    p.out = (float*)d_out;
    unsigned char* w = (unsigned char*)d_ws; size_t off = 0;
    auto take = [&](size_t bytes) { unsigned char* r = w + off; off += (bytes + 255) & ~(size_t)255; return r; };
    p.wt_in = (u16*)take((size_t)EVEN_IN * DM * 2); p.wt_out = (u16*)take((size_t)DM * DM * 2); p.xb = (u16*)take((size_t)NTOK * DM * 2);
    p.h = (u16*)take((size_t)NTOK * EVEN_IN * 2); p.mix = (u16*)take((size_t)NTOK * DM * 2); p.rope = (float*)take((size_t)NTOK * 16 * 4);
    p.vstat = (float*)take((size_t)NTOK * 2 * 4); p.barw = (unsigned*)take((size_t)XCD_BAR_WORDS * 4); p.part = (float*)take((size_t)NTOK * 16 * 4); p.wpT = (u16*)take((size_t)4 * 65536 * 2);
    p.xcv = (u16*)take((size_t)NTOK * 1024 * 2);
    if (off > ws_size) { fprintf(stderr, "workspace too small: need %zu have %zu\n", off, ws_size); return; }
    if (hipMemsetAsync(p.barw, 0, (size_t)XCD_BAR_WORDS * 4, stream) != hipSuccess) { fprintf(stderr, "memset failed\n"); return; }
    a.lo = 0; a.hi = NSLOT; a.fuse = (grid == 256) ? 1 : 0; void* args[] = {&a};
    hipError_t e = hipLaunchCooperativeKernel((const void*)k_mega, dim3(grid), dim3(512), args, LDS_BYTES, stream);
    if (e != hipSuccess) fprintf(stderr, "cooperative launch failed: %s (grid %d)\n", hipGetErrorString(e), grid);
}
```
